# Optimizing an MI355X kernel written in HIP

```python
import jax, jax.numpy as jnp
from jax import lax
import numpy as np

D_MODEL = 2048
BATCH = 4
SEQ = 4096
DEPTH = 2

MEM_LEN = 256
HEAD_DIM = 64
DIL_GROUPS = ((128, 1), (512, 4), (2048, 16))
A_HEADS_PER_GROUP = 8
A_HEADS = A_HEADS_PER_GROUP * len(DIL_GROUPS)
BAND_BLOCK = 128
CHUNK = 128
B_GROUPS = 8
B_WIDTH = 1024
B_GROUP_DIM = B_WIDTH // B_GROUPS
C_HEADS = D_MODEL // HEAD_DIM
MOBA_BLOCK = 256
MOBA_TOPK = 3
X_HEADS = 4
X_HEAD_DIM = D_MODEL // X_HEADS
D_FF = ((8 * D_MODEL // 3 + 127) // 128) * 128
DEEPNORM_ALPHA = (2 * DEPTH) ** 0.25
DEEPNORM_BETA = (8 * DEPTH) ** -0.25
LN_EPS = 1e-5

A_QKV_WIDTH = 3 * A_HEADS * HEAD_DIM
MIX0_IN = A_QKV_WIDTH + 2 * B_WIDTH
MIX0_OUT = A_HEADS_PER_GROUP * HEAD_DIM + B_WIDTH
MIX1_IN = 3 * C_HEADS * HEAD_DIM
MIX1_OUT = C_HEADS * HEAD_DIM

kernel_name = 'hybrid_dilated_gmlp_moba_deepnorm'


def layer_norm(x, g, b):
    xf = x.astype(jnp.float32)
    mu = jnp.mean(xf, axis=-1, keepdims=True)
    var = jnp.mean(jnp.square(xf - mu), axis=-1, keepdims=True)
    y = (xf - mu) * lax.rsqrt(var + LN_EPS) * g.astype(jnp.float32) + b.astype(jnp.float32)
    return y.astype(x.dtype)


def deepnorm_residual(x, fx, g, b):
    return layer_norm(DEEPNORM_ALPHA * x + fx, g, b)


def swiglu_ffn(x, w_in, w_out):
    gate, up = jnp.split(x @ w_in, 2, axis=-1)
    return (jax.nn.silu(gate) * up) @ w_out


def dilated_window_attention(q, k, v, window, dilation):
    B, S, H, hd = q.shape
    L = S // dilation
    Lp = -(-L // BAND_BLOCK) * BAND_BLOCK
    nblk = Lp // BAND_BLOCK
    max_off = window // dilation

    def to_blocks(t):
        t = t.reshape(B, L, dilation, H, hd).transpose(0, 2, 3, 1, 4)
        t = jnp.pad(t, ((0, 0), (0, 0), (0, 0), (0, Lp - L), (0, 0)))
        return t.reshape(B, dilation, H, nblk, BAND_BLOCK, hd)

    def with_prev(t):
        prev = jnp.pad(t, ((0, 0), (0, 0), (0, 0), (1, 0), (0, 0), (0, 0)))[:, :, :, :-1]
        return jnp.concatenate([prev, t], axis=4)

    qb = to_blocks(q)
    kc = with_prev(to_blocks(k))
    vc = with_prev(to_blocks(v))
    s = jnp.einsum('bdhnqc,bdhnkc->bdhnqk', qb, kc).astype(jnp.float32) * (hd ** -0.5)
    qi = jnp.arange(BAND_BLOCK)[:, None]
    ki = jnp.arange(2 * BAND_BLOCK)[None, :]
    off = qi + BAND_BLOCK - ki
    band = (off >= 0) & (off <= max_off)
    has_prev = (jnp.arange(nblk) > 0)[:, None, None] | (ki >= BAND_BLOCK)[None]
    mask = band[None] & has_prev
    s = jnp.where(mask, s, -jnp.inf)
    lse = jax.nn.logsumexp(s, axis=-1)
    p = jnp.exp(s - lse[..., None]).astype(v.dtype)
    o = jnp.einsum('bdhnqk,bdhnkc->bdhnqc', p, vc)
    o = o.reshape(B, dilation, H, Lp, hd)[:, :, :, :L].transpose(0, 3, 1, 2, 4).reshape(B, S, H, hd)
    lse = lse.reshape(B, dilation, H, Lp)[:, :, :, :L].transpose(0, 3, 1, 2).reshape(B, S, H)
    return o, lse


def mixer_a(q, k, v):
    outs, lses = [], []
    for g, (window, dilation) in enumerate(DIL_GROUPS):
        sl = slice(g * A_HEADS_PER_GROUP, (g + 1) * A_HEADS_PER_GROUP)
        o, l = dilated_window_attention(q[:, :, sl], k[:, :, sl], v[:, :, sl], window, dilation)
        outs.append(o)
        lses.append(l)
    w = jax.nn.softmax(jnp.stack(lses, axis=0), axis=0).astype(q.dtype)
    return jnp.einsum('gbsh,gbshc->bshc', w, jnp.stack(outs, axis=0))


def mixer_b(u, v, ln_g, ln_b, w_s, b_s):
    Bsz, S, _ = u.shape
    u = jax.nn.gelu(u)
    v = layer_norm(jax.nn.gelu(v), ln_g, ln_b)
    nc = S // CHUNK
    vc = v.reshape(Bsz, nc, CHUNK, B_GROUPS, B_GROUP_DIM)
    tri = jnp.tril(jnp.ones((CHUNK, CHUNK), dtype=bool))
    w = jnp.where(tri[None], w_s, 0)
    mixed = jnp.einsum('gij,bnjgc->bnigc', w, vc) + b_s.T[None, None, :, :, None]
    return u * mixed.reshape(Bsz, S, B_WIDTH)


def moba_attention(q, k, v):
    B, S, H, hd = q.shape
    Sp = -(-S // MOBA_BLOCK) * MOBA_BLOCK
    nb = Sp // MOBA_BLOCK
    kt = min(MOBA_TOPK, nb)
    scale = hd ** -0.5

    def to_blocks(t):
        t = jnp.pad(t, ((0, 0), (0, Sp - S), (0, 0), (0, 0))).transpose(0, 2, 1, 3)
        return t.reshape(B * H, nb, MOBA_BLOCK, hd)

    qb, kb, vb = to_blocks(q), to_blocks(k), to_blocks(v)
    kmean = jnp.mean(kb.astype(jnp.float32), axis=2).astype(kb.dtype)
    gate = jnp.einsum('znqc,zmc->znqm', qb, kmean).astype(jnp.float32)
    past = jnp.arange(nb)[None, :] < jnp.arange(nb)[:, None]
    gate = jnp.where(past[None, :, None, :], gate, -jnp.inf)
    top_val, top_idx = lax.top_k(gate, kt)
    sel_ok = jnp.isfinite(top_val)
    causal = jnp.tril(jnp.ones((MOBA_BLOCK, MOBA_BLOCK), dtype=bool))

    def attend_block(args):
        z, qc, idx, ok, k_own, v_own = args
        k_sel = kb[z][idx]
        v_sel = vb[z][idx]
        s_sel = jnp.einsum('qc,qjkc->qjk', qc, k_sel).astype(jnp.float32) * scale
        s_sel = jnp.where(ok[:, :, None], s_sel, -jnp.inf).reshape(MOBA_BLOCK, kt * MOBA_BLOCK)
        s_own = jnp.where(causal, (qc @ k_own.T).astype(jnp.float32) * scale, -jnp.inf)
        p = jax.nn.softmax(jnp.concatenate([s_sel, s_own], axis=-1), axis=-1).astype(v_own.dtype)
        p_sel = p[:, :kt * MOBA_BLOCK].reshape(MOBA_BLOCK, kt, MOBA_BLOCK)
        p_own = p[:, kt * MOBA_BLOCK:]
        return jnp.einsum('qjk,qjkc->qc', p_sel, v_sel) + p_own @ v_own

    n_items = B * H * nb
    z_idx = jnp.repeat(jnp.arange(B * H), nb)
    out = lax.map(attend_block, (z_idx,
                                 qb.reshape(n_items, MOBA_BLOCK, hd),
                                 top_idx.reshape(n_items, MOBA_BLOCK, kt),
                                 sel_ok.reshape(n_items, MOBA_BLOCK, kt),
                                 kb.reshape(n_items, MOBA_BLOCK, hd),
                                 vb.reshape(n_items, MOBA_BLOCK, hd)))
    return out.reshape(B, H, Sp, hd).transpose(0, 2, 1, 3)[:, :S]


def token_mix_even(x, w_in, gmlp_ln_g, gmlp_ln_b, gmlp_w_s, gmlp_b_s, w_out):
    B, S, _ = x.shape
    h = x @ w_in
    qkv, u, v = jnp.split(h, [A_QKV_WIDTH, A_QKV_WIDTH + B_WIDTH], axis=-1)
    qkv = qkv.reshape(B, S, 3, A_HEADS, HEAD_DIM)
    a_out = mixer_a(qkv[:, :, 0], qkv[:, :, 1], qkv[:, :, 2]).reshape(B, S, A_HEADS_PER_GROUP * HEAD_DIM)
    b_out = mixer_b(u, v, gmlp_ln_g, gmlp_ln_b, gmlp_w_s, gmlp_b_s)
    return jnp.concatenate([a_out, b_out], axis=-1) @ w_out


def token_mix_odd(x, w_in, w_out):
    B, S, _ = x.shape
    qkv = (x @ w_in).reshape(B, S, 3, C_HEADS, HEAD_DIM)
    o = moba_attention(qkv[:, :, 0], qkv[:, :, 1], qkv[:, :, 2])
    return o.reshape(B, S, MIX1_OUT) @ w_out


def memory_cross_attention(x, mem, w_q, w_kv, w_o):
    B, S, _ = x.shape
    M = mem.shape[1]
    q = (x @ w_q).reshape(B, S, X_HEADS, X_HEAD_DIM)
    k, v = jnp.split(mem @ w_kv, 2, axis=-1)
    k = k.reshape(B, M, X_HEADS, X_HEAD_DIM)
    v = v.reshape(B, M, X_HEADS, X_HEAD_DIM)
    s = jnp.einsum('bshc,bmhc->bhsm', q, k).astype(jnp.float32) * (X_HEAD_DIM ** -0.5)
    p = jax.nn.softmax(s, axis=-1).astype(v.dtype)
    o = jnp.einsum('bhsm,bmhc->bshc', p, v).reshape(B, S, D_MODEL)
    return o @ w_o


def hybrid_layer(x, mem, p, even):
    x = deepnorm_residual(x, 0.5 * swiglu_ffn(x, *p['ffn1']), *p['ln1'])
    mixed = token_mix_even(x, *p['mix']) if even else token_mix_odd(x, *p['mix'])
    x = deepnorm_residual(x, mixed, *p['ln2'])
    x = deepnorm_residual(x, memory_cross_attention(x, mem, *p['mem']), *p['ln3'])
    x = deepnorm_residual(x, 0.5 * swiglu_ffn(x, *p['ffn2']), *p['ln4'])
    return x


def setup_inputs(seed: int = 0) -> dict:
    key = jax.random.key(seed)
    keys = iter(jax.random.split(key, 64))

    def normal(shape, scale):
        return jax.random.normal(next(keys), shape, jnp.float32) * scale

    def gain(n):
        return 1.0 + normal((n,), 0.02)

    def bias(n):
        return normal((n,), 0.02)

    inp = {'x': normal((BATCH, SEQ, D_MODEL), 1.0),
           'mem': normal((BATCH, MEM_LEN, D_MODEL), 1.0)}
    for i in range(DEPTH):
        p = 'l%d_' % i
        inp[p + 'ffn1_w_in'] = normal((D_MODEL, 2 * D_FF), D_MODEL ** -0.5)
        inp[p + 'ffn1_w_out'] = normal((D_FF, D_MODEL), D_FF ** -0.5 * DEEPNORM_BETA)
        inp[p + 'ln1_g'] = gain(D_MODEL)
        inp[p + 'ln1_b'] = bias(D_MODEL)
        if i % 2 == 0:
            inp[p + 'mix_w_in'] = normal((D_MODEL, MIX0_IN), D_MODEL ** -0.5)
            inp[p + 'gmlp_ln_g'] = gain(B_WIDTH)
            inp[p + 'gmlp_ln_b'] = bias(B_WIDTH)
            inp[p + 'gmlp_w_s'] = normal((B_GROUPS, CHUNK, CHUNK), CHUNK ** -0.5)
            inp[p + 'gmlp_b_s'] = 1.0 + normal((B_GROUPS, CHUNK), 0.02)
            inp[p + 'mix_w_out'] = normal((MIX0_OUT, D_MODEL), MIX0_OUT ** -0.5 * DEEPNORM_BETA)
        else:
            inp[p + 'mix_w_in'] = normal((D_MODEL, MIX1_IN), D_MODEL ** -0.5)
            inp[p + 'mix_w_out'] = normal((MIX1_OUT, D_MODEL), MIX1_OUT ** -0.5 * DEEPNORM_BETA)
        inp[p + 'ln2_g'] = gain(D_MODEL)
        inp[p + 'ln2_b'] = bias(D_MODEL)
        inp[p + 'mem_w_q'] = normal((D_MODEL, D_MODEL), D_MODEL ** -0.5)
        inp[p + 'mem_w_kv'] = normal((D_MODEL, 2 * D_MODEL), D_MODEL ** -0.5)
        inp[p + 'mem_w_o'] = normal((D_MODEL, D_MODEL), D_MODEL ** -0.5 * DEEPNORM_BETA)
        inp[p + 'ln3_g'] = gain(D_MODEL)
        inp[p + 'ln3_b'] = bias(D_MODEL)
        inp[p + 'ffn2_w_in'] = normal((D_MODEL, 2 * D_FF), D_MODEL ** -0.5)
        inp[p + 'ffn2_w_out'] = normal((D_FF, D_MODEL), D_FF ** -0.5 * DEEPNORM_BETA)
        inp[p + 'ln4_g'] = gain(D_MODEL)
        inp[p + 'ln4_b'] = bias(D_MODEL)
    return inp


def reference(x, mem,
              l0_ffn1_w_in, l0_ffn1_w_out, l0_ln1_g, l0_ln1_b,
              l0_mix_w_in, l0_gmlp_ln_g, l0_gmlp_ln_b, l0_gmlp_w_s, l0_gmlp_b_s, l0_mix_w_out,
              l0_ln2_g, l0_ln2_b, l0_mem_w_q, l0_mem_w_kv, l0_mem_w_o, l0_ln3_g, l0_ln3_b,
              l0_ffn2_w_in, l0_ffn2_w_out, l0_ln4_g, l0_ln4_b,
              l1_ffn1_w_in, l1_ffn1_w_out, l1_ln1_g, l1_ln1_b,
              l1_mix_w_in, l1_mix_w_out,
              l1_ln2_g, l1_ln2_b, l1_mem_w_q, l1_mem_w_kv, l1_mem_w_o, l1_ln3_g, l1_ln3_b,
              l1_ffn2_w_in, l1_ffn2_w_out, l1_ln4_g, l1_ln4_b):
    layers = [
        dict(ffn1=(l0_ffn1_w_in, l0_ffn1_w_out), ln1=(l0_ln1_g, l0_ln1_b),
             mix=(l0_mix_w_in, l0_gmlp_ln_g, l0_gmlp_ln_b, l0_gmlp_w_s, l0_gmlp_b_s, l0_mix_w_out),
             ln2=(l0_ln2_g, l0_ln2_b), mem=(l0_mem_w_q, l0_mem_w_kv, l0_mem_w_o),
             ln3=(l0_ln3_g, l0_ln3_b), ffn2=(l0_ffn2_w_in, l0_ffn2_w_out), ln4=(l0_ln4_g, l0_ln4_b)),
        dict(ffn1=(l1_ffn1_w_in, l1_ffn1_w_out), ln1=(l1_ln1_g, l1_ln1_b),
             mix=(l1_mix_w_in, l1_mix_w_out),
             ln2=(l1_ln2_g, l1_ln2_b), mem=(l1_mem_w_q, l1_mem_w_kv, l1_mem_w_o),
             ln3=(l1_ln3_g, l1_ln3_b), ffn2=(l1_ffn2_w_in, l1_ffn2_w_out), ln4=(l1_ln4_g, l1_ln4_b)),
    ]
    for i in range(DEPTH):
        x = hybrid_layer(x, mem, layers[i], i % 2 == 0)
    return x
```

```cpp
#include <hip/hip_runtime.h>
#include <hip/hip_cooperative_groups.h>
#include <cstdio>
#include <cstdint>
namespace cg = cooperative_groups;

#ifndef PROBE
#define PROBE 0
#endif
#ifndef MK_ONE_LAUNCH
#define MK_ONE_LAUNCH 1
#endif

#define DI __device__ __forceinline__
#define LAS __attribute__((address_space(3)))
typedef unsigned short bf16_t;
typedef short bf16x8 __attribute__((ext_vector_type(8)));
typedef float f32x4 __attribute__((ext_vector_type(4)));
typedef float f32x2 __attribute__((ext_vector_type(2)));
typedef float f32x16 __attribute__((ext_vector_type(16)));
typedef unsigned u32x4 __attribute__((ext_vector_type(4)));
typedef unsigned u32x2 __attribute__((ext_vector_type(2)));
typedef __bf16 bf16x2_t __attribute__((ext_vector_type(2)));

DI unsigned cvtpk(float lo, float hi) { f32x2 v = {lo, hi}; bf16x2_t b = __builtin_convertvector(v, bf16x2_t); return __builtin_bit_cast(unsigned, b); }
DI float bflo(unsigned w) { return __uint_as_float(w << 16); }
DI float bfhi(unsigned w) { return __uint_as_float(w & 0xffff0000u); }
DI float fexp2(float x) { return __builtin_amdgcn_exp2f(x); }
DI float frcp(float x) { return __builtin_amdgcn_rcpf(x); }
DI float wave_sum(float v) {
#pragma unroll
    for (int o = 1; o < 64; o <<= 1) v += __shfl_xor(v, o);
    return v;
}
DI float gelu_t(float x) { const float z = 1.5957691216057308f * (x + 0.044715f * x * x * x); return x * frcp(1.0f + fexp2(-1.4426950408889634f * z)); }
DI float silu_f(float x) { return x * frcp(1.0f + fexp2(-1.4426950408889634f * x)); }

constexpr int TOK = 16384, DM = 2048, DFF = 5504, SEQ = 4096;
constexpr int LD0 = 6656, LD1 = 6144;
constexpr float LN_EPS = 1e-5f;
constexpr float ALPHA = 1.4142135623730951f;

constexpr size_t MiB = 1u << 20;
constexpr size_t WS_KMH = 0, WS_KML = 256 * 1024, WS_GW = 512 * 1024, WS_BAR = 1024 * 1024, BAR_BYTES = 16384, WS_STATS = 768 * 1024, WS_LNG = 896 * 1024, WS_LNB = 904 * 1024;
constexpr size_t WS_MEMB = 2 * MiB, WS_MEMK = 6 * MiB  , WS_MEMVT = 14 * MiB  ;
constexpr size_t WS_W = 22 * MiB, W_LAYER = 195 * MiB;
constexpr size_t WO_FFN1I = 0, WO_FFN1O = 43 * MiB, WO_MIXI = 64 * MiB + MiB / 2, WO_MIXO = 90 * MiB + MiB / 2, WO_MEMQ = 98 * MiB + MiB / 2,
                 WO_MEMKV = 106 * MiB + MiB / 2, WO_MEMO = 122 * MiB + MiB / 2, WO_FFN2I = 130 * MiB + MiB / 2, WO_FFN2O = 173 * MiB + MiB / 2;
constexpr size_t WS_XB = 412 * MiB, WS_AO = 476 * MiB, WS_VT = 540 * MiB, WS_BIG = 604 * MiB, WS_KP = 812 * MiB, WS_END = 813 * MiB;

typedef const char __attribute__((address_space(4)))* kargp_t;
DI kargp_t karg_base() { kargp_t p = (kargp_t)__builtin_amdgcn_kernarg_segment_ptr(); asm volatile("" : "+s"(p)); return p; }
DI const float* karg_in(kargp_t p, int i) { return *(const float* const __attribute__((address_space(4)))*)(p + 8 * i); }
DI float* karg_out(kargp_t p) { return *(float* const __attribute__((address_space(4)))*)(p + 320); }
DI unsigned char* karg_ws(kargp_t p) { return *(unsigned char* const __attribute__((address_space(4)))*)(p + 328); }

namespace pg8 {
constexpr int BM = 256, BK = 64, HALF = 128, HTB = HALF * BK * 2, STAGE_BYTES = 8 * HTB, NXCD = 8, WGM = 4;
DI int lds_byte(int r, int c) { const int st = (r >> 4) * 2 + (c >> 5), rr = r & 15, cc = c & 31, ob = rr * 64 + cc * 2; return st * 1024 + (ob ^ (((ob >> 9) & 1) << 5)); }
DI void stage_rc(int b, int& R, int& C) { const int st = b / 1024, sb = b % 1024, swz = sb ^ (((sb >> 9) & 1) << 5); R = (st >> 1) * 16 + swz / 64; C = (st & 1) * 32 + (swz % 64) / 2; }
DI int perm32(int rho) { const int n = rho >> 4, i = rho & 15; return 8 * (i >> 2) + 4 * n + (i & 3); }

struct Unit { int pm, pn; };
struct Gemm { const bf16_t* A; const bf16_t* Bt; int M, N, K; };

struct StaticOrder {
    int nM, nN, nwg, G, c;
    DI void init(int M, int N, int G_, int c_) { nM = M / BM; nN = N / BM; nwg = nM * nN; G = G_; c = c_; }
    DI bool next(int i, Unit& u) const {
        const long L = (long)i * G + c; if (L >= nwg) return false;
        int wgid = (int)L; { const int q = nwg / NXCD, r = nwg % NXCD, xcd = wgid % NXCD, off = wgid / NXCD; wgid = (xcd < r ? xcd * (q + 1) : r * (q + 1) + (xcd - r) * q) + off; }
        const int nig = WGM * nN, gid = wgid / nig, fm = gid * WGM, gsz = (nM - fm) < WGM ? (nM - fm) : WGM;
        u.pm = fm + ((wgid % nig) % gsz); u.pn = (wgid % nig) / gsz; return true;
    }
};


struct EpiSwiGLU {
    static constexpr bool PERM = true;
    int dummy;
    DI void operator()(const f32x4 (&acc)[2][2][4][2], const Unit& u, int wr, int wc, int fr, int fq) const {
        bf16_t* H = (bf16_t*)(karg_ws(karg_base()) + WS_BIG);
        int row0 = u.pm * BM + wr * 64 + fr, col0 = u.pn * HALF + wc * 32 + 8 * fq;
        asm volatile("" : "+v"(row0), "+v"(col0));
#pragma unroll
        for (int ai = 0; ai < 2; ++ai)
#pragma unroll
            for (int m = 0; m < 4; ++m) {
                bf16_t* rowp = H + (size_t)(row0 + ai * HALF + m * 16) * DFF + col0;
                const f32x4 g0 = acc[ai][0][m][0], g1 = acc[ai][0][m][1], u0 = acc[ai][1][m][0], u1 = acc[ai][1][m][1];
                u32x4 w;
#define SWG(g, u) ((g) * (u) * frcp(1.0f + fexp2(-(g))))
                w.x = cvtpk(SWG(g0[0], u0[0]), SWG(g0[1], u0[1])); w.y = cvtpk(SWG(g0[2], u0[2]), SWG(g0[3], u0[3]));
                w.z = cvtpk(SWG(g1[0], u1[0]), SWG(g1[1], u1[1])); w.w = cvtpk(SWG(g1[2], u1[2]), SWG(g1[3], u1[3]));
#undef SWG
                *(u32x4*)rowp = w;
            }
    }
};
struct EpiResid {
    static constexpr bool PERM = true;
    int flags;
    DI void operator()(const f32x4 (&acc)[2][2][4][2], const Unit& u, int wr, int wc, int fr, int fq) const {
        int row0 = u.pm * BM + wr * 64 + fr, col0 = u.pn * BM + wc * 32 + 8 * fq;
        asm volatile("" : "+v"(row0), "+v"(col0));
        const kargp_t ka = karg_base();
        float* Y = karg_out(ka);
        const float* R = (flags & 1) ? karg_in(ka, 0) : (const float*)Y;
        const unsigned char* wsl = karg_ws(ka);
        const f32x2* stats = (const f32x2*)(wsl + WS_STATS);
        const float scale = (flags & 2) ? 0.5f : 1.0f;
#pragma unroll
        for (int bj = 0; bj < 2; ++bj) {
            int cc = col0 + bj * HALF;
            asm volatile("" : "+v"(cc));
            const f32x4 g0 = *(const f32x4*)((const float*)(wsl + WS_LNG) + cc), g1 = *(const f32x4*)((const float*)(wsl + WS_LNG) + cc + 4);
            const f32x4 b0 = *(const f32x4*)((const float*)(wsl + WS_LNB) + cc), b1 = *(const f32x4*)((const float*)(wsl + WS_LNB) + cc + 4);
#pragma unroll
            for (int ai = 0; ai < 2; ++ai)
#pragma unroll
                for (int m = 0; m < 4; ++m) {
                    const int row = row0 + ai * HALF + m * 16;
                    const f32x2 st = stats[row];
                    const size_t off = (size_t)row * DM + cc;
                    const f32x4 r0 = *(const f32x4*)(R + off), r1 = *(const f32x4*)(R + off + 4);
                    const f32x4 x0 = (r0 - st[0]) * st[1] * g0 + b0, x1 = (r1 - st[0]) * st[1] * g1 + b1;
                    *(f32x4*)(Y + off) = x0 * ALPHA + acc[ai][bj][m][0] * scale;
                    *(f32x4*)(Y + off + 4) = x1 * ALPHA + acc[ai][bj][m][1] * scale;
                }
        }
    }
};
struct EpiBf16V {
    static constexpr bool PERM = true;
    int kind;
    DI void operator()(const f32x4 (&acc)[2][2][4][2], const Unit& u, int wr, int wc, int fr, int fq) const {
        unsigned char* wsl = karg_ws(karg_base());
        bf16_t* O; bf16_t* VT; int ldc, vt_lo, vt_hi, NH, hd_sh, ls, dilated;
        if (kind < 2)       { O = (bf16_t*)(wsl + WS_MEMK + kind * 4 * MiB); VT = (bf16_t*)(wsl + WS_MEMVT + kind * 4 * MiB); ldc = DM; vt_lo = 8; vt_hi = 16; NH = 4; hd_sh = 9; ls = 8; dilated = 0; }
        else if (kind == 2) { O = (bf16_t*)(wsl + WS_BIG); VT = (bf16_t*)(wsl + WS_VT); ldc = LD0; vt_lo = 12; vt_hi = 18; NH = 24; hd_sh = 6; ls = 12; dilated = 1; }
        else if (kind == 3) { O = (bf16_t*)(wsl + WS_BIG); VT = (bf16_t*)(wsl + WS_VT); ldc = LD1; vt_lo = 16; vt_hi = 24; NH = 32; hd_sh = 6; ls = 12; dilated = 0; }
        else                { O = (bf16_t*)(wsl + WS_BIG); VT = (bf16_t*)(wsl + WS_VT); ldc = DM; vt_lo = 0; vt_hi = 0; NH = 1; hd_sh = 6; ls = 12; dilated = 0; }
        int row0 = u.pm * BM + wr * 64 + fr; int fq8 = 8 * fq;
        asm volatile("" : "+v"(row0), "+v"(fq8));
        if (u.pn >= vt_lo && u.pn < vt_hi) {
#pragma unroll
            for (int bj = 0; bj < 2; ++bj) {
                const int vc0 = (u.pn - vt_lo) * BM + bj * HALF + wc * 32 + fq8;
                const int head = vc0 >> hd_sh, d0 = vc0 & ((1 << hd_sh) - 1);
                const int sh = dilated ? 2 * (head >> 3) : 0;
                if (sh == 4) {
#pragma unroll
                    for (int ai = 0; ai < 2; ++ai) {
                        const int row = row0 + ai * HALF;
                        const int b = row >> ls, t = row & ((1 << ls) - 1);
                        const int pos = ((t & 15) << (ls - 4)) | (t >> 4);
                        bf16_t* p = VT + ((((size_t)(b * NH + head) << hd_sh) + d0) << ls) + pos;
#pragma unroll
                        for (int e = 0; e < 8; ++e) {
                            u32x2 w; w.x = cvtpk(acc[ai][bj][0][e >> 2][e & 3], acc[ai][bj][1][e >> 2][e & 3]); w.y = cvtpk(acc[ai][bj][2][e >> 2][e & 3], acc[ai][bj][3][e >> 2][e & 3]);
                            *(u32x2*)(p + ((size_t)e << ls)) = w;
                        }
                    }
                } else
#pragma unroll
                for (int ai = 0; ai < 2; ++ai)
#pragma unroll
                    for (int m = 0; m < 4; ++m) {
                        const int row = row0 + ai * HALF + m * 16;
                        const int b = row >> ls, t = row & ((1 << ls) - 1);
                        const int pos = ((t & ((1 << sh) - 1)) << (ls - sh)) | (t >> sh);
                        bf16_t* p = VT + ((((size_t)(b * NH + head) << hd_sh) + d0) << ls) + pos;
#pragma unroll
                        for (int e = 0; e < 8; ++e) p[(size_t)e << ls] = (bf16_t)(cvtpk(acc[ai][bj][m][e >> 2][e & 3], 0.f) & 0xffffu);
                    }
            }
        } else {
            if (kind == 3 && u.pn >= 8) {
                float* kp = (float*)(wsl + WS_KP) + ((size_t)(u.pm * 2 + wr) * 2048) + (u.pn - 8) * BM + wc * 32 + fq8;
#pragma unroll
                for (int bj = 0; bj < 2; ++bj)
#pragma unroll
                    for (int n = 0; n < 2; ++n) {
                        f32x4 cs = (f32x4){0.f, 0.f, 0.f, 0.f};
#pragma unroll
                        for (int ai = 0; ai < 2; ++ai)
#pragma unroll
                            for (int m = 0; m < 4; ++m) cs += acc[ai][bj][m][n];
#pragma unroll
                        for (int e = 0; e < 4; ++e) { float v = cs[e]; v += __shfl_xor(v, 1); v += __shfl_xor(v, 2); v += __shfl_xor(v, 4); v += __shfl_xor(v, 8); cs[e] = v; }
                        if (fr == 0) *(f32x4*)(kp + bj * HALF + 4 * n) = cs;
                    }
            }
            const int col0 = u.pn * BM + wc * 32 + fq8;
#pragma unroll
            for (int ai = 0; ai < 2; ++ai)
#pragma unroll
                for (int m = 0; m < 4; ++m) {
                    bf16_t* rowp = O + (size_t)(row0 + ai * HALF + m * 16) * ldc + col0;
#pragma unroll
                    for (int bj = 0; bj < 2; ++bj) {
                        const f32x4 v0 = acc[ai][bj][m][0], v1 = acc[ai][bj][m][1];
                        u32x4 w; w.x = cvtpk(v0[0], v0[1]); w.y = cvtpk(v0[2], v0[3]); w.z = cvtpk(v1[0], v1[1]); w.w = cvtpk(v1[2], v1[3]);
                        *(u32x4*)(rowp + bj * HALF) = w;
                    }
                }
        }
    }
};

template <class Epi>
DI void gemm_phase(LAS unsigned char* lds, const Gemm g, const StaticOrder& S, const Epi& E, const int tid) {
    const int wid = __builtin_amdgcn_readfirstlane(tid >> 6), lane = tid & 63, wr = wid >> 2, wc = wid & 3, fr = lane & 15, fq = lane >> 4;
    const int K = g.K, nt = K / BK;
    unsigned voffA[2], voffB[2];
#pragma unroll
    for (int i = 0; i < 2; ++i) { int R, C; stage_rc(tid * 16 + i * 8192, R, C); const int Rb = Epi::PERM ? ((R & ~31) + perm32(R & 31)) : R;
        voffA[i] = (unsigned)(R * K + C) * 2u; voffB[i] = (unsigned)(Rb * K + C) * 2u; }
    const size_t kstep = (size_t)(BK * 2);
    const size_t hstep = (size_t)HALF * K * 2;
    const size_t tstep = 2 * hstep;
    const unsigned ldsw = (unsigned)wid * 1024u;
    const int aoff = lds_byte(wr * 64 + fr, fq * 8), boff = lds_byte(wc * 32 + fr, fq * 8);
#define PG8_SA(b, h) (((b) * 2 + (h)) * HTB)
#define PG8_SB(b, h) ((4 + (b) * 2 + (h)) * HTB)
#define PG8_STAGE(bufoff, gbase, voff) do { _Pragma("unroll") for (int _i = 0; _i < 2; ++_i) \
        __builtin_amdgcn_global_load_lds((const unsigned*)((const char*)(gbase) + (voff)[_i]), (LAS unsigned*)(lds + (bufoff) + ldsw + _i * 8192), 16, 0, 0); } while (0)
#define PG8_LDA(dst, b, h) do { _Pragma("unroll") for (int m = 0; m < 4; ++m) _Pragma("unroll") for (int k = 0; k < 2; ++k) dst[m][k] = *(const LAS bf16x8*)(lds + PG8_SA(b, h) + aoff + m * 2048 + k * 1024); } while (0)
#define PG8_LDB(dst, b, h) do { _Pragma("unroll") for (int n = 0; n < 2; ++n) _Pragma("unroll") for (int k = 0; k < 2; ++k) dst[n][k] = *(const LAS bf16x8*)(lds + PG8_SB(b, h) + boff + n * 2048 + k * 1024); } while (0)
#define PG8_MMA(ai, bj, At, Bt) do { __builtin_amdgcn_s_setprio(1); _Pragma("unroll") for (int m = 0; m < 4; ++m) _Pragma("unroll") for (int n = 0; n < 2; ++n) _Pragma("unroll") for (int k = 0; k < 2; ++k) \
        acc[ai][bj][m][n] = __builtin_amdgcn_mfma_f32_16x16x32_bf16(Bt[n][k], At[m][k], acc[ai][bj][m][n], 0, 0, 0); __builtin_amdgcn_s_setprio(0); } while (0)
#define PG8_WAIT_V(n) asm volatile("s_waitcnt vmcnt(" #n ")" ::: "memory")
#define PG8_WAIT_L(n) asm volatile("s_waitcnt lgkmcnt(" #n ")" ::: "memory")
#define PG8_BAR __builtin_amdgcn_s_barrier()
#define PG8_SCHED __builtin_amdgcn_sched_barrier(0)
    Unit cur, nxt; int ui = 0;
    if (!S.next(0, cur)) return;
    f32x4 acc[2][2][4][2];
#pragma unroll
    for (int a = 0; a < 2; ++a)
#pragma unroll
        for (int b = 0; b < 2; ++b)
#pragma unroll
            for (int m = 0; m < 4; ++m)
#pragma unroll
                for (int n = 0; n < 2; ++n) acc[a][b][m][n] = (f32x4){0.f, 0.f, 0.f, 0.f};
    bf16x8 At[4][2], B0[2][2], B1[2][2];
    const char* cA = (const char*)g.A + (size_t)cur.pm * tstep; const char* cB = (const char*)g.Bt + (size_t)cur.pn * tstep;
    PG8_STAGE(PG8_SB(0, 0), cB, voffB); PG8_STAGE(PG8_SB(0, 1), cB + hstep, voffB); PG8_STAGE(PG8_SA(0, 0), cA, voffA); PG8_STAGE(PG8_SA(0, 1), cA + hstep, voffA);
    if (wr == 1) PG8_BAR;
    PG8_WAIT_V(2); PG8_BAR;
    PG8_STAGE(PG8_SB(1, 0), cB + kstep, voffB); PG8_STAGE(PG8_SA(1, 0), cA + kstep, voffA); PG8_STAGE(PG8_SB(1, 1), cB + hstep + kstep, voffB);
    PG8_WAIT_V(6); PG8_BAR;
    for (;;) {
        const bool has_next = S.next(ui + 1, nxt);
        const char* nA = has_next ? (const char*)g.A + (size_t)nxt.pm * tstep : cA; const char* nB = has_next ? (const char*)g.Bt + (size_t)nxt.pn * tstep : cB;
        for (int t = 0; t < nt; t += 2) {
            const bool last = (t == nt - 2);
            const char* a1 = cA + (size_t)(t + 1) * kstep;
            const char* a2 = last ? nA : cA + (size_t)(t + 2) * kstep; const char* b2 = last ? nB : cB + (size_t)(t + 2) * kstep;
            const char* a3 = a2 + kstep; const char* b3 = b2 + kstep;
            PG8_LDB(B0, 0, 0); PG8_LDB(B1, 0, 1); PG8_SCHED; PG8_LDA(At, 0, 0); PG8_STAGE(PG8_SA(1, 1), a1 + hstep, voffA);
            PG8_WAIT_V(8); PG8_WAIT_L(0); PG8_BAR; PG8_MMA(0, 0, At, B0); PG8_MMA(0, 1, At, B1); PG8_BAR; PG8_SCHED;
            PG8_LDA(At, 0, 1); PG8_STAGE(PG8_SB(0, 0), b2, voffB); PG8_STAGE(PG8_SB(0, 1), b2 + hstep, voffB); PG8_STAGE(PG8_SA(0, 0), a2, voffA);
            PG8_WAIT_V(8); PG8_WAIT_L(0); PG8_BAR; PG8_MMA(1, 0, At, B0); PG8_MMA(1, 1, At, B1); PG8_BAR; PG8_SCHED;
            PG8_LDB(B0, 1, 0); PG8_LDB(B1, 1, 1); PG8_SCHED; PG8_LDA(At, 1, 0); PG8_STAGE(PG8_SA(0, 1), a2 + hstep, voffA);
            PG8_WAIT_V(8); PG8_WAIT_L(0); PG8_BAR; PG8_MMA(0, 0, At, B0); PG8_MMA(0, 1, At, B1); PG8_BAR; PG8_SCHED;
            PG8_LDA(At, 1, 1); PG8_STAGE(PG8_SB(1, 0), b3, voffB); PG8_STAGE(PG8_SB(1, 1), b3 + hstep, voffB); PG8_STAGE(PG8_SA(1, 0), a3, voffA);
            PG8_WAIT_V(8); PG8_WAIT_L(0); PG8_BAR; PG8_MMA(1, 0, At, B0); PG8_MMA(1, 1, At, B1); PG8_BAR; PG8_SCHED;
        }
        if (wr == 0) PG8_BAR;
        E(acc, cur, wr, wc, fr, fq);
        if (!has_next) break;
#pragma unroll
        for (int a = 0; a < 2; ++a)
#pragma unroll
            for (int b = 0; b < 2; ++b)
#pragma unroll
                for (int m = 0; m < 4; ++m)
#pragma unroll
                    for (int n = 0; n < 2; ++n) acc[a][b][m][n] = (f32x4){0.f, 0.f, 0.f, 0.f};
        cur = nxt; cA = nA; cB = nB; ++ui;
        if (wr == 1) PG8_BAR;
    }
    PG8_WAIT_V(0);
    PG8_BAR;
#undef PG8_SA
#undef PG8_SB
#undef PG8_STAGE
#undef PG8_LDA
#undef PG8_LDB
#undef PG8_MMA
#undef PG8_WAIT_V
#undef PG8_WAIT_L
#undef PG8_BAR
#undef PG8_SCHED
}
}

#define MFMA32(a, b, c) __builtin_amdgcn_mfma_f32_32x32x16_bf16((a), (b), (c), 0, 0, 0)
DI int pi32(int rho) { return (rho & ~12) | ((rho & 4) << 1) | ((rho & 8) >> 1); }
DI int kofs(int i, int h) { return 16 * (i >> 3) + 8 * h + (i & 7); }
DI float xhalf_max(float m) { auto rr = __builtin_amdgcn_permlane32_swap(__float_as_uint(m), __float_as_uint(m), false, false); return fmaxf(__uint_as_float(rr[0]), __uint_as_float(rr[1])); }
DI bf16x8 pack8(const f32x16& p, int s) {
    u32x4 w; w.x = cvtpk(p[8 * s], p[8 * s + 1]); w.y = cvtpk(p[8 * s + 2], p[8 * s + 3]); w.z = cvtpk(p[8 * s + 4], p[8 * s + 5]); w.w = cvtpk(p[8 * s + 6], p[8 * s + 7]);
    return __builtin_bit_cast(bf16x8, w);
}
DI void softmax_pv(const f32x16& s, float& m_run, float& l_run, f32x16& o0, f32x16& o1, bf16x8 v00, bf16x8 v01, bf16x8 v10, bf16x8 v11) {
    float mx = s[0];
#pragma unroll
    for (int i = 1; i < 16; ++i) mx = fmaxf(mx, s[i]);
    mx = xhalf_max(mx);
    const float mnew = fmaxf(m_run, mx);
    const float alpha = fexp2(m_run - mnew);
    m_run = mnew;
    f32x16 p; float sum = 0.f;
#pragma unroll
    for (int i = 0; i < 16; ++i) { p[i] = fexp2(s[i] - mnew); sum += p[i]; }
    l_run = l_run * alpha + sum;
    if (__any(alpha != 1.0f)) { o0 = o0 * alpha; o1 = o1 * alpha; }
    const bf16x8 pb0 = pack8(p, 0), pb1 = pack8(p, 1);
    o0 = MFMA32(v00, pb0, o0); o0 = MFMA32(v01, pb1, o0);
    o1 = MFMA32(v10, pb0, o1); o1 = MFMA32(v11, pb1, o1);
}
DI void store_o64(bf16_t* orow, const f32x16& o0, const f32x16& o1, float inv, int h) {
#pragma unroll
    for (int g4 = 0; g4 < 4; ++g4) {
        u32x2 w0, w1;
        w0.x = cvtpk(o0[4 * g4] * inv, o0[4 * g4 + 1] * inv); w0.y = cvtpk(o0[4 * g4 + 2] * inv, o0[4 * g4 + 3] * inv);
        w1.x = cvtpk(o1[4 * g4] * inv, o1[4 * g4 + 1] * inv); w1.y = cvtpk(o1[4 * g4 + 2] * inv, o1[4 * g4 + 3] * inv);
        *(u32x2*)(orow + 8 * g4 + 4 * h) = w0;
        *(u32x2*)(orow + 32 + 8 * g4 + 4 * h) = w1;
    }
}

DI void mixer_a_item(int item, const bf16_t* QKV, const bf16_t* VT, bf16_t* AO, int lane) {
    const int qs = item & 7, r = (item >> 3) & 15, j = (item >> 7) & 7, b = item >> 10;
    const int ql = lane & 31, h = lane >> 5;
    const float C = 0.125f * 1.4426950408889634f;
    const int tq = 16 * (32 * qs + ql) + r;
    float m_run = -1e30f, l_run = 0.f; f32x16 o0, o1;
#pragma unroll
    for (int i = 0; i < 16; ++i) { o0[i] = 0.f; o1[i] = 0.f; }
#pragma unroll 1
    for (int g = 0; g < 3; ++g) {
        const int sh = 2 * g, dil = 1 << sh, Lg = SEQ >> sh, head = 8 * g + j, rg = r & (dil - 1);
        const int mq = tq >> sh, mq_min = (512 * qs + r) >> sh, mq_max = (16 * (32 * qs + 31) + r) >> sh;
        int klo = mq_min - 128; klo = klo < 0 ? 0 : klo; klo &= ~31;
        const bf16_t* qp = QKV + (size_t)(b * SEQ + tq) * LD0 + head * 64 + 8 * h;
        bf16x8 qf[4];
#pragma unroll
        for (int jj = 0; jj < 4; ++jj) qf[jj] = *(const bf16x8*)(qp + 16 * jj);
        const bf16_t* kbase = QKV + (size_t)(b * SEQ + rg) * LD0 + 1536 + head * 64 + 8 * h;
        const bf16_t* vbase = VT + ((size_t)((b * 24 + head) * 64 + ql) << 12) + rg * Lg + 8 * h;
#pragma unroll 1
        for (int kt = klo; kt <= mq_max; kt += 32) {
            const bf16_t* kp = kbase + (size_t)((kt + pi32(ql)) << sh) * LD0;
            bf16x8 kf[4];
#pragma unroll
            for (int jj = 0; jj < 4; ++jj) kf[jj] = *(const bf16x8*)(kp + 16 * jj);
            const bf16_t* vp = vbase + kt;
            const bf16x8 v00 = *(const bf16x8*)(vp), v01 = *(const bf16x8*)(vp + 16);
            const bf16x8 v10 = *(const bf16x8*)(vp + ((size_t)32 << 12)), v11 = *(const bf16x8*)(vp + ((size_t)32 << 12) + 16);
            f32x16 s;
#pragma unroll
            for (int i = 0; i < 16; ++i) s[i] = 0.f;
#pragma unroll
            for (int jj = 0; jj < 4; ++jj) s = MFMA32(kf[jj], qf[jj], s);
#pragma unroll
            for (int i = 0; i < 16; ++i) { const int dist = mq - (kt + kofs(i, h)); s[i] = (dist >= 0 && dist <= 128) ? s[i] * C : -INFINITY; }
            softmax_pv(s, m_run, l_run, o0, o1, v00, v01, v10, v11);
        }
    }
    const float l = l_run + __shfl_xor(l_run, 32);
    store_o64(AO + (size_t)(b * SEQ + tq) * 1536 + j * 64, o0, o1, 1.0f / l, h);
}

DI void gmlp_unit(int unit, bool reuse, const bf16_t* QKV, const bf16_t* Wb, const float* lng, const float* lnb, const float* bs, bf16_t* AO,
                  LAS unsigned char* lds, int wave, int lane) {
    const int gp = unit & 3, n = (unit >> 2) & 31, b = unit >> 7;
    LAS f32x2* STl = (LAS f32x2*)(lds + 69632);
    LAS bf16_t* VTl = (LAS bf16_t*)lds;
    const size_t row0 = (size_t)b * SEQ + 128 * n;
    const f32x4 gam = *(const f32x4*)(lng + 256 * gp + 4 * lane), bet = *(const f32x4*)(lnb + 256 * gp + 4 * lane);
#pragma unroll 4
    for (int tt = 0; tt < 16; ++tt) {
        const int tok = 16 * wave + tt;
        const bf16_t* vr = QKV + (row0 + tok) * LD0 + 5632;
        float mean, rstd;
        if (!reuse) {
            const u32x4 a = *(const u32x4*)(vr + 8 * lane), c = *(const u32x4*)(vr + 512 + 8 * lane);
            float x[16];
#pragma unroll
            for (int e = 0; e < 4; ++e) { x[2 * e] = gelu_t(bflo(a[e])); x[2 * e + 1] = gelu_t(bfhi(a[e])); x[8 + 2 * e] = gelu_t(bflo(c[e])); x[9 + 2 * e] = gelu_t(bfhi(c[e])); }
            float s = 0.f;
#pragma unroll
            for (int e = 0; e < 16; ++e) s += x[e];
            mean = wave_sum(s) * (1.0f / 1024.0f);
            float s2 = 0.f;
#pragma unroll
            for (int e = 0; e < 16; ++e) { const float d = x[e] - mean; s2 += d * d; }
            rstd = 1.0f / sqrtf(wave_sum(s2) * (1.0f / 1024.0f) + LN_EPS);
            if (lane == 0) STl[tok] = (f32x2){mean, rstd};
        } else { const f32x2 st = STl[tok]; mean = st[0]; rstd = st[1]; }
        const u32x2 raw = *(const u32x2*)(vr + 256 * gp + 4 * lane);
        const float y0 = (gelu_t(bflo(raw.x)) - mean) * rstd * gam[0] + bet[0], y1 = (gelu_t(bfhi(raw.x)) - mean) * rstd * gam[1] + bet[1];
        const float y2 = (gelu_t(bflo(raw.y)) - mean) * rstd * gam[2] + bet[2], y3 = (gelu_t(bfhi(raw.y)) - mean) * rstd * gam[3] + bet[3];
        const unsigned w01 = cvtpk(y0, y1), w23 = cvtpk(y2, y3);
        VTl[(4 * lane + 0) * 136 + tok] = (bf16_t)(w01 & 0xffffu); VTl[(4 * lane + 1) * 136 + tok] = (bf16_t)(w01 >> 16);
        VTl[(4 * lane + 2) * 136 + tok] = (bf16_t)(w23 & 0xffffu); VTl[(4 * lane + 3) * 136 + tok] = (bf16_t)(w23 >> 16);
    }
    __syncthreads();
    {
        const int ql = lane & 31, h = lane >> 5, g = 2 * gp + (wave >> 2);
        const LAS bf16_t* arow = VTl + (32 * wave + ql) * 136 + 8 * h;
#pragma unroll 1
        for (int it = 0; it < 4; ++it) {
            const int i = 32 * it + ql;
            const bf16_t* wrow = Wb + ((size_t)g * 128 + i) * 128 + 8 * h;
            f32x16 acc;
#pragma unroll
            for (int e = 0; e < 16; ++e) acc[e] = 0.f;
            bf16x8 wf[8];
#pragma unroll
            for (int js = 0; js < 8; ++js) if (js <= 2 * it + 1) wf[js] = *(const bf16x8*)(wrow + 16 * js);
#pragma unroll
            for (int js = 0; js < 8; ++js) if (js <= 2 * it + 1) acc = MFMA32(*(const LAS bf16x8*)(arow + 16 * js), wf[js], acc);
            const float bias = bs[g * 128 + i];
            const bf16_t* urow = QKV + (row0 + i) * LD0 + 4608 + 256 * gp + 32 * wave + 4 * h;
            bf16_t* orow = AO + (row0 + i) * 1536 + 512 + 256 * gp + 32 * wave + 4 * h;
#pragma unroll
            for (int qd = 0; qd < 4; ++qd) {
                const u32x2 uu = *(const u32x2*)(urow + 8 * qd);
                u32x2 w;
                w.x = cvtpk(gelu_t(bflo(uu.x)) * (acc[4 * qd] + bias), gelu_t(bfhi(uu.x)) * (acc[4 * qd + 1] + bias));
                w.y = cvtpk(gelu_t(bflo(uu.y)) * (acc[4 * qd + 2] + bias), gelu_t(bfhi(uu.y)) * (acc[4 * qd + 3] + bias));
                *(u32x2*)(orow + 8 * qd) = w;
            }
        }
    }
    __syncthreads();
}

DI void kmean_item(int item, const bf16_t* QKV, bf16_t* KMH, bf16_t* KML, int lane) {
    const int blk = item & 15, hh = (item >> 4) & 31, b = item >> 9;
    const int dc = lane & 7, rgp = lane >> 3;
    const bf16_t* kp = QKV + (size_t)(b * SEQ + 256 * blk + rgp) * LD1 + 2048 + hh * 64 + 8 * dc;
    float s[8];
#pragma unroll
    for (int e = 0; e < 8; ++e) s[e] = 0.f;
#pragma unroll 8
    for (int i = 0; i < 32; ++i) {
        const u32x4 v = *(const u32x4*)(kp + (size_t)(8 * i) * LD1);
#pragma unroll
        for (int e = 0; e < 4; ++e) { s[2 * e] += bflo(v[e]); s[2 * e + 1] += bfhi(v[e]); }
    }
#pragma unroll
    for (int e = 0; e < 8; ++e) { s[e] += __shfl_xor(s[e], 8); s[e] += __shfl_xor(s[e], 16); s[e] += __shfl_xor(s[e], 32); s[e] *= (1.0f / 256.0f); }
    if (rgp == 0) {
        u32x4 hi, lo;
#pragma unroll
        for (int e = 0; e < 4; ++e) {
            const unsigned hw = cvtpk(s[2 * e], s[2 * e + 1]); hi[e] = hw;
            lo[e] = cvtpk(s[2 * e] - bflo(hw), s[2 * e + 1] - bfhi(hw));
        }
        const size_t o = (size_t)item * 64 + 8 * dc;
        *(u32x4*)(KMH + o) = hi; *(u32x4*)(KML + o) = lo;
    }
}

DI void moba_item(int b, int hh, int qs, const bf16_t* QKV, const bf16_t* VT, const bf16_t* KMH, const bf16_t* KML, bf16_t* AO, int lane) {
    const int ql = lane & 31, h = lane >> 5, n = qs >> 3, sub = qs & 7;
    const float C = 0.125f * 1.4426950408889634f;
    const int tq = 32 * qs + ql;
    const bf16_t* qp = QKV + (size_t)(b * SEQ + tq) * LD1 + hh * 64 + 8 * h;
    bf16x8 qf[4];
#pragma unroll
    for (int jj = 0; jj < 4; ++jj) qf[jj] = *(const bf16x8*)(qp + 16 * jj);
    unsigned sel = 0u;
    if (n > 0) {
        const int blk = (ql & 3) + 4 * (ql >> 3);
        const bool rowok = ((ql & 4) == 0);
        const float* kp0 = (const float*)KMH + ((size_t)((b * 16 + blk) * 2) * 2048) + hh * 64 + 8 * h;
        f32x16 G;
#pragma unroll
        for (int i = 0; i < 16; ++i) G[i] = 0.f;
#pragma unroll
        for (int jj = 0; jj < 4; ++jj) {
            bf16x8 kh = (bf16x8){0, 0, 0, 0, 0, 0, 0, 0}, kl = kh;
            if (rowok) {
                const f32x4 a0 = *(const f32x4*)(kp0 + 16 * jj), a1 = *(const f32x4*)(kp0 + 16 * jj + 4);
                const f32x4 c0 = *(const f32x4*)(kp0 + 2048 + 16 * jj), c1 = *(const f32x4*)(kp0 + 2048 + 16 * jj + 4);
                const f32x4 m0 = (a0 + c0) * (1.0f / 256.0f), m1 = (a1 + c1) * (1.0f / 256.0f);
                u32x4 hi, lo;
                hi.x = cvtpk(m0[0], m0[1]); hi.y = cvtpk(m0[2], m0[3]); hi.z = cvtpk(m1[0], m1[1]); hi.w = cvtpk(m1[2], m1[3]);
                lo.x = cvtpk(m0[0] - bflo(hi.x), m0[1] - bfhi(hi.x)); lo.y = cvtpk(m0[2] - bflo(hi.y), m0[3] - bfhi(hi.y));
                lo.z = cvtpk(m1[0] - bflo(hi.z), m1[1] - bfhi(hi.z)); lo.w = cvtpk(m1[2] - bflo(hi.w), m1[3] - bfhi(hi.w));
                kh = __builtin_bit_cast(bf16x8, hi); kl = __builtin_bit_cast(bf16x8, lo);
            }
            G = MFMA32(kh, qf[jj], G); G = MFMA32(kl, qf[jj], G);
        }
#pragma unroll
        for (int pick = 0; pick < 3; ++pick) {
            float best = -INFINITY; int bi = -1;
#pragma unroll
            for (int i = 0; i < 16; ++i) { const bool ok = (i < n) && !((sel >> i) & 1u) && (G[i] > best); best = ok ? G[i] : best; bi = ok ? i : bi; }
            if (bi >= 0) sel |= 1u << bi;
        }
        sel = (unsigned)__shfl((int)sel, ql);
    }
    unsigned uni = sel;
#pragma unroll
    for (int o = 1; o < 32; o <<= 1) uni |= (unsigned)__shfl_xor((int)uni, o);
    uni = (unsigned)__builtin_amdgcn_readfirstlane((int)uni);
    float m_run = -1e30f, l_run = 0.f; f32x16 o0, o1;
#pragma unroll
    for (int i = 0; i < 16; ++i) { o0[i] = 0.f; o1[i] = 0.f; }
    const bf16_t* kbase = QKV + (size_t)(b * SEQ + pi32(ql)) * LD1 + 2048 + hh * 64 + 8 * h;
    const bf16_t* vbase = VT + ((size_t)((b * 32 + hh) * 64 + ql) << 12) + 8 * h;
#pragma unroll 1
    for (int blk = 0; blk <= n; ++blk) {
        const bool own = (blk == n);
        if (!own && !((uni >> blk) & 1u)) continue;
        const bool mine = own || ((sel >> blk) & 1u);
        const int ntile = own ? sub + 1 : 8;
#pragma unroll 1
        for (int kt8 = 0; kt8 < ntile; ++kt8) {
            const int key0 = 256 * blk + 32 * kt8;
            const bf16_t* kp = kbase + (size_t)key0 * LD1;
            bf16x8 kf[4];
#pragma unroll
            for (int jj = 0; jj < 4; ++jj) kf[jj] = *(const bf16x8*)(kp + 16 * jj);
            const bf16_t* vp = vbase + key0;
            const bf16x8 v00 = *(const bf16x8*)(vp), v01 = *(const bf16x8*)(vp + 16);
            const bf16x8 v10 = *(const bf16x8*)(vp + ((size_t)32 << 12)), v11 = *(const bf16x8*)(vp + ((size_t)32 << 12) + 16);
            f32x16 s;
#pragma unroll
            for (int i = 0; i < 16; ++i) s[i] = 0.f;
#pragma unroll
            for (int jj = 0; jj < 4; ++jj) s = MFMA32(kf[jj], qf[jj], s);
            const bool diag = own && (kt8 == sub);
#pragma unroll
            for (int i = 0; i < 16; ++i) { const bool ok = mine && (!diag || kofs(i, h) <= ql); s[i] = ok ? s[i] * C : -INFINITY; }
            softmax_pv(s, m_run, l_run, o0, o1, v00, v01, v10, v11);
        }
    }
    const float l = l_run + __shfl_xor(l_run, 32);
    store_o64(AO + (size_t)(b * SEQ + tq) * DM + hh * 64, o0, o1, 1.0f / l, h);
}

#define LBAR() do { asm volatile("s_waitcnt lgkmcnt(0)" ::: "memory"); __builtin_amdgcn_s_barrier(); asm volatile("" ::: "memory"); } while (0)
DI void moba_unit(int b, int hh, int n, const bf16_t* QKV, const bf16_t* VT, const bf16_t* KMH, const bf16_t* KML, bf16_t* AO,
                  LAS unsigned char* lds, int tid, int wave, int lane) {
    const int ql = lane & 31, h = lane >> 5;
    const float C = 0.125f * 1.4426950408889634f;
    const int qin = 32 * wave + ql, tq = 256 * n + qin;
    const int lrow = tid >> 3, lch = tid & 7;
    const bf16_t* kgb = QKV + (size_t)(b * SEQ) * LD1 + 2048 + hh * 64;
    const bf16_t* vgb = VT + ((size_t)((b * 32 + hh) * 64) << 12);
    const unsigned kgo = (unsigned)(lrow * LD1 + 8 * lch), vgo = (unsigned)((lrow << 12) + 8 * lch);
    LAS unsigned char* kw = lds + lrow * 144 + lch * 16;
    LAS unsigned char* vw = kw + 36864;
    const LAS unsigned char* kr = lds + pi32(ql) * 144 + 16 * h;
    const LAS unsigned char* vr = lds + 36864 + ql * 144 + 16 * h;
#define LD_TILE(T, RK, RV) do { const int key0_ = 64 * (T); RK = *(const bf16x8*)(kgb + (size_t)key0_ * LD1 + kgo); RV = *(const bf16x8*)(vgb + key0_ + vgo); } while (0)
#define ST_TILE(buf, RK, RV) do { *(LAS bf16x8*)(kw + (buf) * 9216) = RK; *(LAS bf16x8*)(vw + (buf) * 9216) = RV; } while (0)
    const int ntiles = 4 * (n + 1);
    bf16x8 rkA, rvA, rkB, rvB;
    LD_TILE(0, rkA, rvA); LD_TILE(1, rkB, rvB);
    const bf16_t* qp = QKV + (size_t)(b * SEQ + tq) * LD1 + hh * 64 + 8 * h;
    bf16x8 qf[4];
#pragma unroll
    for (int jj = 0; jj < 4; ++jj) qf[jj] = *(const bf16x8*)(qp + 16 * jj);
    unsigned sel = 0u;
    if (n > 0) {
        const int blk = (ql & 3) + 4 * (ql >> 3);
        const bool rowok = ((ql & 4) == 0);
        const float* kp0 = (const float*)KMH + ((size_t)((b * 16 + blk) * 2) * 2048) + hh * 64 + 8 * h;
        f32x16 Gt;
#pragma unroll
        for (int i = 0; i < 16; ++i) Gt[i] = 0.f;
#pragma unroll
        for (int jj = 0; jj < 4; ++jj) {
            bf16x8 kh = (bf16x8){0, 0, 0, 0, 0, 0, 0, 0}, kl = kh;
            if (rowok) {
                const f32x4 a0 = *(const f32x4*)(kp0 + 16 * jj), a1 = *(const f32x4*)(kp0 + 16 * jj + 4);
                const f32x4 c0 = *(const f32x4*)(kp0 + 2048 + 16 * jj), c1 = *(const f32x4*)(kp0 + 2048 + 16 * jj + 4);
                const f32x4 m0 = (a0 + c0) * (1.0f / 256.0f), m1 = (a1 + c1) * (1.0f / 256.0f);
                u32x4 hi, lo;
                hi.x = cvtpk(m0[0], m0[1]); hi.y = cvtpk(m0[2], m0[3]); hi.z = cvtpk(m1[0], m1[1]); hi.w = cvtpk(m1[2], m1[3]);
                lo.x = cvtpk(m0[0] - bflo(hi.x), m0[1] - bfhi(hi.x)); lo.y = cvtpk(m0[2] - bflo(hi.y), m0[3] - bfhi(hi.y));
                lo.z = cvtpk(m1[0] - bflo(hi.z), m1[1] - bfhi(hi.z)); lo.w = cvtpk(m1[2] - bflo(hi.w), m1[3] - bfhi(hi.w));
                kh = __builtin_bit_cast(bf16x8, hi); kl = __builtin_bit_cast(bf16x8, lo);
            }
            Gt = MFMA32(kh, qf[jj], Gt); Gt = MFMA32(kl, qf[jj], Gt);
        }
#pragma unroll
        for (int pick = 0; pick < 3; ++pick) {
            float best = -INFINITY; int bi = -1;
#pragma unroll
            for (int i = 0; i < 16; ++i) { const bool ok = (i < n) && !((sel >> i) & 1u) && (Gt[i] > best); best = ok ? Gt[i] : best; bi = ok ? i : bi; }
            if (bi >= 0) sel |= 1u << bi;
        }
        sel = (unsigned)__shfl((int)sel, ql);
    }
    unsigned uni = sel;
#pragma unroll
    for (int o = 1; o < 32; o <<= 1) uni |= (unsigned)__shfl_xor((int)uni, o);
    uni = (unsigned)__builtin_amdgcn_readfirstlane((int)uni);
    float m_run = -1e30f, l_run = 0.f; f32x16 o0, o1;
#pragma unroll
    for (int i = 0; i < 16; ++i) { o0[i] = 0.f; o1[i] = 0.f; }
#define MOBA_KLD(koff, KF) do { const LAS unsigned char* kb_ = kr + (koff); \
        _Pragma("unroll") for (int jj = 0; jj < 4; ++jj) { KF[2 * jj] = *(const LAS bf16x8*)(kb_ + jj * 32); KF[2 * jj + 1] = *(const LAS bf16x8*)(kb_ + 32 * 144 + jj * 32); } } while (0)
#define MOBA_VLD(voff, VF) do { const LAS unsigned char* vb_ = vr + (voff); \
        VF[0] = *(const LAS bf16x8*)(vb_); VF[1] = *(const LAS bf16x8*)(vb_ + 32); VF[2] = *(const LAS bf16x8*)(vb_ + 64); VF[3] = *(const LAS bf16x8*)(vb_ + 96); \
        VF[4] = *(const LAS bf16x8*)(vb_ + 32 * 144); VF[5] = *(const LAS bf16x8*)(vb_ + 32 * 144 + 32); VF[6] = *(const LAS bf16x8*)(vb_ + 32 * 144 + 64); VF[7] = *(const LAS bf16x8*)(vb_ + 32 * 144 + 96); } while (0)
#define MOBA_QK(KF, S0, S1) do { \
        _Pragma("unroll") for (int i = 0; i < 16; ++i) { S0[i] = 0.f; S1[i] = 0.f; } \
        _Pragma("unroll") for (int jj = 0; jj < 4; ++jj) { S0 = MFMA32(KF[2 * jj], qf[jj], S0); S1 = MFMA32(KF[2 * jj + 1], qf[jj], S1); } } while (0)
#define MOBA_SMPV(T, VF, s0_, s1_) do { \
        const int blk_ = (T) >> 2, kt_ = (T) & 3; const bool own_ = (blk_ == n); \
        const bool act_ = own_ ? (64 * kt_ <= 32 * wave + 31) : (((uni >> blk_) & 1u) != 0u); \
        if (act_) { \
            const bool mine_ = own_ || (((sel >> blk_) & 1u) != 0u); \
            float mnew_; \
            if (own_ && (64 * kt_ + 63 > 32 * wave)) {              \
                const int lim_ = qin - 64 * kt_ - 8 * h; \
                _Pragma("unroll") for (int i = 0; i < 16; ++i) { \
                    const int kc_ = 16 * (i >> 3) + (i & 7); \
                    s0_[i] = (kc_ <= lim_) ? s0_[i] * C : -INFINITY; s1_[i] = (kc_ + 32 <= lim_) ? s1_[i] * C : -INFINITY; } \
                float mx_ = fmaxf(s0_[0], s1_[0]); \
                _Pragma("unroll") for (int i = 1; i < 16; ++i) mx_ = fmaxf(fmaxf(mx_, s0_[i]), s1_[i]); \
                mx_ = xhalf_max(mx_); \
                mnew_ = fmaxf(m_run, mx_); \
                _Pragma("unroll") for (int i = 0; i < 16; ++i) { s0_[i] = fexp2(s0_[i] - mnew_); s1_[i] = fexp2(s1_[i] - mnew_); } \
            } else {                                                \
                float mx_ = fmaxf(s0_[0], s1_[0]); \
                _Pragma("unroll") for (int i = 1; i < 16; ++i) mx_ = fmaxf(fmaxf(mx_, s0_[i]), s1_[i]); \
                mx_ = mine_ ? mx_ * C : -INFINITY; \
                mx_ = xhalf_max(mx_); \
                mnew_ = fmaxf(m_run, mx_); \
                const float nb_ = mine_ ? -mnew_ : -INFINITY; \
                s0_ = s0_ * C + nb_; s1_ = s1_ * C + nb_; \
                _Pragma("unroll") for (int i = 0; i < 16; ++i) { s0_[i] = fexp2(s0_[i]); s1_[i] = fexp2(s1_[i]); } \
            } \
            const float alpha_ = fexp2(m_run - mnew_); m_run = mnew_; \
            const f32x16 ps_ = s0_ + s1_; \
            const float sum_ = ((ps_[0] + ps_[1]) + (ps_[2] + ps_[3])) + ((ps_[4] + ps_[5]) + (ps_[6] + ps_[7])) + ((ps_[8] + ps_[9]) + (ps_[10] + ps_[11])) + ((ps_[12] + ps_[13]) + (ps_[14] + ps_[15])); \
            l_run = l_run * alpha_ + sum_; \
            if (__any(alpha_ != 1.0f)) { o0 = o0 * alpha_; o1 = o1 * alpha_; } \
            const bf16x8 p00_ = pack8(s0_, 0), p01_ = pack8(s0_, 1), p10_ = pack8(s1_, 0), p11_ = pack8(s1_, 1); \
            o0 = MFMA32(VF[0], p00_, o0); o0 = MFMA32(VF[1], p01_, o0); o0 = MFMA32(VF[2], p10_, o0); o0 = MFMA32(VF[3], p11_, o0); \
            o1 = MFMA32(VF[4], p00_, o1); o1 = MFMA32(VF[5], p01_, o1); o1 = MFMA32(VF[6], p10_, o1); o1 = MFMA32(VF[7], p11_, o1); \
        } } while (0)
    asm volatile("" :: "v"(qf[0]), "v"(qf[1]), "v"(qf[2]), "v"(qf[3]));
    const int lastT = ntiles - 1;
#define MOBA_PAIR(T, offA, offB) do { \
        const int blk_ = (T) >> 2; \
        if (((uni >> blk_) & 1u) != 0u) { \
            const bool mine_ = (((sel >> blk_) & 1u) != 0u); \
            const LAS unsigned char* ka_ = kr + (offA); const LAS unsigned char* kb_ = kr + (offB); \
            f32x16 a0_, a1_, b0_, b1_; \
            _Pragma("unroll") for (int i = 0; i < 16; ++i) { a0_[i] = 0.f; a1_[i] = 0.f; b0_[i] = 0.f; b1_[i] = 0.f; } \
            _Pragma("unroll") for (int jj = 0; jj < 4; ++jj) { \
                a0_ = MFMA32(*(const LAS bf16x8*)(ka_ + jj * 32), qf[jj], a0_); b0_ = MFMA32(*(const LAS bf16x8*)(kb_ + jj * 32), qf[jj], b0_); \
                a1_ = MFMA32(*(const LAS bf16x8*)(ka_ + 32 * 144 + jj * 32), qf[jj], a1_); b1_ = MFMA32(*(const LAS bf16x8*)(kb_ + 32 * 144 + jj * 32), qf[jj], b1_); } \
            float mxa_ = fmaxf(a0_[0], a1_[0]), mxb_ = fmaxf(b0_[0], b1_[0]); \
            _Pragma("unroll") for (int i = 1; i < 16; ++i) { mxa_ = fmaxf(fmaxf(mxa_, a0_[i]), a1_[i]); mxb_ = fmaxf(fmaxf(mxb_, b0_[i]), b1_[i]); } \
            float mx_ = fmaxf(mxa_, mxb_); \
            mx_ = mine_ ? mx_ * C : -INFINITY; \
            mx_ = xhalf_max(mx_); \
            const float mnew_ = fmaxf(m_run, mx_); \
            const float nb_ = mine_ ? -mnew_ : -INFINITY; \
            a0_ = a0_ * C + nb_; b0_ = b0_ * C + nb_; a1_ = a1_ * C + nb_; b1_ = b1_ * C + nb_; \
            _Pragma("unroll") for (int i = 0; i < 16; ++i) { a0_[i] = fexp2(a0_[i]); b0_[i] = fexp2(b0_[i]); a1_[i] = fexp2(a1_[i]); b1_[i] = fexp2(b1_[i]); } \
            const float alpha_ = fexp2(m_run - mnew_); m_run = mnew_; \
            const f32x16 ps_ = (a0_ + a1_) + (b0_ + b1_); \
            const float sum_ = ((ps_[0] + ps_[1]) + (ps_[2] + ps_[3])) + ((ps_[4] + ps_[5]) + (ps_[6] + ps_[7])) + ((ps_[8] + ps_[9]) + (ps_[10] + ps_[11])) + ((ps_[12] + ps_[13]) + (ps_[14] + ps_[15])); \
            l_run = l_run * alpha_ + sum_; \
            if (__any(alpha_ != 1.0f)) { o0 = o0 * alpha_; o1 = o1 * alpha_; } \
            const LAS unsigned char* va_ = vr + (offA); const LAS unsigned char* vb_ = vr + (offB); \
            { const bf16x8 p_ = pack8(a0_, 0); o0 = MFMA32(*(const LAS bf16x8*)(va_), p_, o0); o1 = MFMA32(*(const LAS bf16x8*)(va_ + 32 * 144), p_, o1); } \
            { const bf16x8 p_ = pack8(a0_, 1); o0 = MFMA32(*(const LAS bf16x8*)(va_ + 32), p_, o0); o1 = MFMA32(*(const LAS bf16x8*)(va_ + 32 * 144 + 32), p_, o1); } \
            { const bf16x8 p_ = pack8(a1_, 0); o0 = MFMA32(*(const LAS bf16x8*)(va_ + 64), p_, o0); o1 = MFMA32(*(const LAS bf16x8*)(va_ + 32 * 144 + 64), p_, o1); } \
            { const bf16x8 p_ = pack8(a1_, 1); o0 = MFMA32(*(const LAS bf16x8*)(va_ + 96), p_, o0); o1 = MFMA32(*(const LAS bf16x8*)(va_ + 32 * 144 + 96), p_, o1); } \
            { const bf16x8 p_ = pack8(b0_, 0); o0 = MFMA32(*(const LAS bf16x8*)(vb_), p_, o0); o1 = MFMA32(*(const LAS bf16x8*)(vb_ + 32 * 144), p_, o1); } \
            { const bf16x8 p_ = pack8(b0_, 1); o0 = MFMA32(*(const LAS bf16x8*)(vb_ + 32), p_, o0); o1 = MFMA32(*(const LAS bf16x8*)(vb_ + 32 * 144 + 32), p_, o1); } \
            { const bf16x8 p_ = pack8(b1_, 0); o0 = MFMA32(*(const LAS bf16x8*)(vb_ + 64), p_, o0); o1 = MFMA32(*(const LAS bf16x8*)(vb_ + 32 * 144 + 64), p_, o1); } \
            { const bf16x8 p_ = pack8(b1_, 1); o0 = MFMA32(*(const LAS bf16x8*)(vb_ + 96), p_, o0); o1 = MFMA32(*(const LAS bf16x8*)(vb_ + 32 * 144 + 96), p_, o1); } \
        } } while (0)
#define MOBA_ONE(T, off) do { f32x16 s0_, s1_; bf16x8 kf_[8]; MOBA_KLD(off, kf_); MOBA_QK(kf_, s0_, s1_); \
        { bf16x8 vf_[8]; MOBA_VLD(off, vf_); MOBA_SMPV(T, vf_, s0_, s1_); } } while (0)
    ST_TILE(0, rkA, rvA); ST_TILE(1, rkB, rvB);
    LD_TILE(2, rkA, rvA); LD_TILE(3, rkB, rvB);
    LBAR();
    int pc = 0;
#pragma unroll 1
    for (int T = 0; T < ntiles; T += 2) {
        if ((T >> 2) < n) { MOBA_PAIR(T, pc, pc + 9216); }
        else { MOBA_ONE(T, pc); MOBA_ONE(T + 1, pc + 9216); }
        const int pnx = pc ^ 18432;
        *(LAS bf16x8*)(kw + pnx) = rkA; *(LAS bf16x8*)(vw + pnx) = rvA; *(LAS bf16x8*)(kw + pnx + 9216) = rkB; *(LAS bf16x8*)(vw + pnx + 9216) = rvB;
        { const int Ta = (T + 4 < lastT) ? T + 4 : lastT, Tb = (T + 5 < lastT) ? T + 5 : lastT; LD_TILE(Ta, rkA, rvA); LD_TILE(Tb, rkB, rvB); }
        LBAR();
        pc = pnx;
    }
#undef MOBA_PAIR
#undef MOBA_ONE
#define MOBA_ROT() do {} while (0)
#undef MOBA_ROT
#undef MOBA_QK
#undef MOBA_KLD
#undef MOBA_VLD
#undef MOBA_SMPV
#define MOBA_COMPUTE_UNUSED
#undef MOBA_COMPUTE_UNUSED
#undef LD_TILE
#undef ST_TILE
    const float l = l_run + __shfl_xor(l_run, 32);
    store_o64(AO + (size_t)(b * SEQ + tq) * DM + hh * 64, o0, o1, 1.0f / l, h);
}

DI void xattn_item(int item, const bf16_t* QX, const bf16_t* MK, const bf16_t* MVT, bf16_t* AO, int lane) {
    const int qs = item & 127, hx = (item >> 7) & 3, b = item >> 9;
    const int ql = lane & 31, h = lane >> 5;
    const float C = 0.04419417382415922f * 1.4426950408889634f;
    const int tq = 32 * qs + ql;
    const bf16_t* qp = QX + (size_t)(b * SEQ + tq) * DM + hx * 512 + 8 * h;
    const bf16_t* kp = MK + (size_t)(b * 256 + pi32(ql)) * DM + hx * 512 + 8 * h;
    f32x16 S[8];
#pragma unroll
    for (int kt = 0; kt < 8; ++kt)
#pragma unroll
        for (int i = 0; i < 16; ++i) S[kt][i] = 0.f;
#pragma unroll 2
    for (int jj = 0; jj < 32; ++jj) {
        const bf16x8 qf = *(const bf16x8*)(qp + 16 * jj);
#pragma unroll
        for (int kt = 0; kt < 8; ++kt) {
            const bf16x8 kf = *(const bf16x8*)(kp + (size_t)(32 * kt) * DM + 16 * jj);
            S[kt] = MFMA32(kf, qf, S[kt]);
        }
    }
    float mx = S[0][0];
#pragma unroll
    for (int kt = 0; kt < 8; ++kt)
#pragma unroll
        for (int i = 0; i < 16; ++i) mx = fmaxf(mx, S[kt][i]);
    mx = fmaxf(mx, __shfl_xor(mx, 32));
    const float mc = mx * C;
    float sum = 0.f;
    bf16x8 pb[8][2];
#pragma unroll
    for (int kt = 0; kt < 8; ++kt) {
#pragma unroll
        for (int i = 0; i < 16; ++i) { S[kt][i] = fexp2(S[kt][i] * C - mc); sum += S[kt][i]; }
        pb[kt][0] = pack8(S[kt], 0); pb[kt][1] = pack8(S[kt], 1);
    }
    sum += __shfl_xor(sum, 32);
    const float inv = 1.0f / sum;
    const bf16_t* vp = MVT + ((size_t)((b * 4 + hx) * 512 + ql) << 8) + 8 * h;
    bf16_t* orow = AO + (size_t)(b * SEQ + tq) * DM + hx * 512 + 4 * h;
#pragma unroll 1
    for (int dt = 0; dt < 16; ++dt) {
        f32x16 acc;
#pragma unroll
        for (int i = 0; i < 16; ++i) acc[i] = 0.f;
        const bf16_t* vr = vp + ((size_t)(32 * dt) << 8);
#pragma unroll
        for (int kt = 0; kt < 8; ++kt) {
            const bf16x8 v0 = *(const bf16x8*)(vr + 32 * kt), v1 = *(const bf16x8*)(vr + 32 * kt + 16);
            acc = MFMA32(v0, pb[kt][0], acc); acc = MFMA32(v1, pb[kt][1], acc);
        }
#pragma unroll
        for (int g4 = 0; g4 < 4; ++g4) {
            u32x2 w; w.x = cvtpk(acc[4 * g4] * inv, acc[4 * g4 + 1] * inv); w.y = cvtpk(acc[4 * g4 + 2] * inv, acc[4 * g4 + 3] * inv);
            *(u32x2*)(orow + 32 * dt + 8 * g4) = w;
        }
    }
}

DI void xattn_unit(int unit, const bf16_t* QX, const bf16_t* MK, const bf16_t* MVT, bf16_t* AOp, LAS unsigned char* lds, int tid, int wave, int lane) {
    constexpr int BUFB = 36864;
    const int qb = unit & 15, hx = (unit >> 4) & 3, b = unit >> 6;
    const int ql = lane & 31, h = lane >> 5;
    const float C = 0.04419417382415922f * 1.4426950408889634f;
    const int tq = 256 * qb + 32 * wave + ql;
    const bf16_t* kg = MK + (size_t)(b * 256 + (tid >> 1)) * DM + hx * 512 + 32 * (tid & 1);
    const bf16_t* vg = MVT + ((size_t)((b * 4 + hx) * 512 + (tid >> 3)) << 8) + 32 * (tid & 7);
    LAS unsigned char* kw = lds + (tid >> 1) * 144 + (tid & 1) * 64;
    LAS unsigned char* vw = lds + (tid >> 3) * 528 + (tid & 7) * 64;
    const LAS unsigned char* kr = lds + pi32(ql) * 144 + 16 * h;
    const LAS unsigned char* vr = lds + ql * 528 + 16 * h;
    const bf16_t* qp = QX + (size_t)(b * SEQ + tq) * DM + hx * 512 + 8 * h;
    bf16_t* orow = AOp + (size_t)(b * SEQ + tq) * DM + hx * 512 + 4 * h;
#define XLD(T, R) do { if ((T) < 8) { _Pragma("unroll") for (int i_ = 0; i_ < 4; ++i_) R[i_] = *(const bf16x8*)(kg + 64 * (T) + 8 * i_); } \
                       else { _Pragma("unroll") for (int i_ = 0; i_ < 4; ++i_) R[i_] = *(const bf16x8*)(vg + ((size_t)(64 * ((T) - 8)) << 8) + 8 * i_); } } while (0)
#define XST(T, buf, R) do { if ((T) < 8) { _Pragma("unroll") for (int i_ = 0; i_ < 4; ++i_) *(LAS bf16x8*)(kw + (buf) * BUFB + 16 * i_) = R[i_]; } \
                            else { _Pragma("unroll") for (int i_ = 0; i_ < 4; ++i_) *(LAS bf16x8*)(vw + (buf) * BUFB + 16 * i_) = R[i_]; } } while (0)
    bf16x8 RA[4], RB[4], qf[4];
    f32x16 S[8];
    bf16x8 pb[8][2];
    float inv = 0.f;
#pragma unroll
    for (int kt = 0; kt < 8; ++kt)
#pragma unroll
        for (int i = 0; i < 16; ++i) S[kt][i] = 0.f;
    XLD(0, RA); XLD(1, RB);
#pragma unroll
    for (int jj = 0; jj < 4; ++jj) qf[jj] = *(const bf16x8*)(qp + 16 * jj);
    XST(0, 0, RA); XLD(2, RA);
    LBAR();
#define XCOMP(T, buf) do { \
        if ((T) < 8) { \
            _Pragma("unroll") for (int jj = 0; jj < 4; ++jj) \
                _Pragma("unroll") for (int kt = 0; kt < 8; ++kt) { \
                    const bf16x8 kf_ = *(const LAS bf16x8*)(kr + (buf) * BUFB + (32 * kt) * 144 + jj * 32); \
                    S[kt] = MFMA32(kf_, qf[jj], S[kt]); } \
            if ((T) + 1 < 8) { _Pragma("unroll") for (int jj = 0; jj < 4; ++jj) qf[jj] = *(const bf16x8*)(qp + 64 * ((T) + 1) + 16 * jj); } \
            if ((T) == 7) { \
                float mx_ = S[0][0]; \
                _Pragma("unroll") for (int kt = 0; kt < 8; ++kt) _Pragma("unroll") for (int i = 0; i < 16; ++i) mx_ = fmaxf(mx_, S[kt][i]); \
                mx_ = xhalf_max(mx_); \
                const float mc_ = -mx_ * C; float sum_ = 0.f; \
                _Pragma("unroll") for (int kt = 0; kt < 8; ++kt) { \
                    S[kt] = S[kt] * C + mc_; \
                    _Pragma("unroll") for (int i = 0; i < 16; ++i) { S[kt][i] = fexp2(S[kt][i]); sum_ += S[kt][i]; } \
                    pb[kt][0] = pack8(S[kt], 0); pb[kt][1] = pack8(S[kt], 1); } \
                sum_ += __shfl_xor(sum_, 32); inv = 1.0f / sum_; } \
        } else { \
            _Pragma("unroll") for (int dt2 = 0; dt2 < 2; ++dt2) { \
                f32x16 acc_; \
                _Pragma("unroll") for (int i = 0; i < 16; ++i) acc_[i] = 0.f; \
                _Pragma("unroll") for (int kt = 0; kt < 8; ++kt) { \
                    const bf16x8 v0_ = *(const LAS bf16x8*)(vr + (buf) * BUFB + (32 * dt2) * 528 + 64 * kt); \
                    const bf16x8 v1_ = *(const LAS bf16x8*)(vr + (buf) * BUFB + (32 * dt2) * 528 + 64 * kt + 32); \
                    acc_ = MFMA32(v0_, pb[kt][0], acc_); acc_ = MFMA32(v1_, pb[kt][1], acc_); } \
                _Pragma("unroll") for (int g4 = 0; g4 < 4; ++g4) { \
                    u32x2 w_; w_.x = cvtpk(acc_[4 * g4] * inv, acc_[4 * g4 + 1] * inv); w_.y = cvtpk(acc_[4 * g4 + 2] * inv, acc_[4 * g4 + 3] * inv); \
                    *(u32x2*)(orow + 64 * ((T) - 8) + 32 * dt2 + 8 * g4) = w_; } } \
        } } while (0)
#define XSTEP2(T) do { \
        XCOMP((T), 0); XST((T) + 1, 1, RB); if ((T) + 3 < 16) XLD((T) + 3, RB); LBAR(); \
        XCOMP((T) + 1, 1); if ((T) + 2 < 16) { XST((T) + 2, 0, RA); if ((T) + 4 < 16) XLD((T) + 4, RA); } LBAR(); } while (0)
    XSTEP2(0); XSTEP2(2); XSTEP2(4); XSTEP2(6); XSTEP2(8); XSTEP2(10); XSTEP2(12); XSTEP2(14);
#undef XSTEP2
#undef XCOMP
#undef XLD
#undef XST
}

DI void ln_rows(const float* y, float* xo, bf16_t* xb, f32x2* stats, const float* gam, const float* bet, int gw, int ngw, int lane) {
    if (gw == 0) {
        f32x4* lg = (f32x4*)((char*)stats + (WS_LNG - WS_STATS)); f32x4* lb = (f32x4*)((char*)stats + (WS_LNB - WS_STATS));
#pragma unroll
        for (int j = 0; j < 8; ++j) { lg[lane + 64 * j] = ((const f32x4*)gam)[lane + 64 * j]; lb[lane + 64 * j] = ((const f32x4*)bet)[lane + 64 * j]; }
    }
    f32x4 gq[8], bq[8];
#pragma unroll
    for (int j = 0; j < 8; ++j) { gq[j] = ((const f32x4*)gam)[lane + 64 * j]; bq[j] = ((const f32x4*)bet)[lane + 64 * j]; }
    for (int row = gw; row < TOK; row += 2 * ngw) {
        const int row2 = row + ngw;
        const bool has2 = row2 < TOK;
        const f32x4* yr = (const f32x4*)(y + (size_t)row * DM) + lane;
        const f32x4* yr2 = (const f32x4*)(y + (size_t)(has2 ? row2 : row) * DM) + lane;
        f32x4 v[8], w[8]; float s = 0.f, t = 0.f;
#pragma unroll
        for (int j = 0; j < 8; ++j) { v[j] = yr[64 * j]; w[j] = yr2[64 * j]; }
#pragma unroll
        for (int j = 0; j < 8; ++j) { s += (v[j][0] + v[j][1]) + (v[j][2] + v[j][3]); t += (w[j][0] + w[j][1]) + (w[j][2] + w[j][3]); }
        const float mean = wave_sum(s) * (1.0f / DM), mean2 = wave_sum(t) * (1.0f / DM);
        float s2 = 0.f, t2 = 0.f;
#pragma unroll
        for (int j = 0; j < 8; ++j) { v[j] = v[j] - mean; s2 += (v[j][0] * v[j][0] + v[j][1] * v[j][1]) + (v[j][2] * v[j][2] + v[j][3] * v[j][3]);
                                      w[j] = w[j] - mean2; t2 += (w[j][0] * w[j][0] + w[j][1] * w[j][1]) + (w[j][2] * w[j][2] + w[j][3] * w[j][3]); }
        const float rstd = 1.0f / sqrtf(wave_sum(s2) * (1.0f / DM) + LN_EPS), rstd2 = 1.0f / sqrtf(wave_sum(t2) * (1.0f / DM) + LN_EPS);
        if (xb && lane == 0) { stats[row] = (f32x2){mean, rstd}; if (has2) stats[row2] = (f32x2){mean2, rstd2}; }
        u32x2* br = (u32x2*)(xb + (size_t)row * DM) + lane;
        u32x2* br2 = (u32x2*)(xb + (size_t)row2 * DM) + lane;
#pragma unroll
        for (int j = 0; j < 8; ++j) {
            const f32x4 g = gq[j], bb = bq[j];
            const f32x4 o = v[j] * rstd * g + bb, o2 = w[j] * rstd2 * g + bb;
            if (xo) { ((f32x4*)(xo + (size_t)row * DM) + lane)[64 * j] = o; if (has2) ((f32x4*)(xo + (size_t)row2 * DM) + lane)[64 * j] = o2; }
            if (xb) { u32x2 p; p.x = cvtpk(o[0], o[1]); p.y = cvtpk(o[2], o[3]); br[64 * j] = p;
            if (has2) { u32x2 q; q.x = cvtpk(o2[0], o2[1]); q.y = cvtpk(o2[2], o2[3]); br2[64 * j] = q; } }
        }
    }
}

DI void transpose_item(const float* W, int K, int N, bf16_t* WT, int mode, LAS float* scr, int item, int lane) {
    const int nblk = N / 32, kb = item / nblk, nb = item - kb * nblk, k0 = 64 * kb, n0 = 32 * nb;
    int drow0 = n0;
    const float wsc = (mode == 1) ? (n0 < DFF ? 1.4426950408889634f : 0.6931471805599453f) : 1.0f;
    if (mode == 1) { if (n0 < DFF) drow0 = (n0 >> 7) * 256 + (n0 & 127); else { const int n1 = n0 - DFF; drow0 = (n1 >> 7) * 256 + 128 + (n1 & 127); } }
    const float* src = W + (size_t)(k0 + (lane >> 5)) * N + n0 + (lane & 31);
#pragma unroll 16
    for (int i = 0; i < 32; ++i) scr[(2 * i + (lane >> 5)) * 33 + (lane & 31)] = src[(size_t)(2 * i) * N];
    asm volatile("s_waitcnt lgkmcnt(0)" ::: "memory");
    const int c = lane & 7;
#pragma unroll
    for (int j = 0; j < 4; ++j) {
        const int n = (lane >> 3) + 8 * j; const LAS float* s = scr + (8 * c) * 33 + n;
        u32x4 o; o.x = cvtpk(s[0 * 33] * wsc, s[1 * 33] * wsc); o.y = cvtpk(s[2 * 33] * wsc, s[3 * 33] * wsc); o.z = cvtpk(s[4 * 33] * wsc, s[5 * 33] * wsc); o.w = cvtpk(s[6 * 33] * wsc, s[7 * 33] * wsc);
        *(u32x4*)(WT + (size_t)(drow0 + n) * K + k0 + 8 * c) = o;
    }
    asm volatile("s_waitcnt lgkmcnt(0)" ::: "memory");
}
DI void cvt_rows(const float* src, bf16_t* dst, size_t n8, int gt, int ngt) {
    size_t i = gt;
    for (; i + 3 * (size_t)ngt < n8; i += 4 * (size_t)ngt) {
        f32x4 a[4], b[4];
#pragma unroll
        for (int u = 0; u < 4; ++u) { a[u] = ((const f32x4*)src)[2 * (i + u * (size_t)ngt)]; b[u] = ((const f32x4*)src)[2 * (i + u * (size_t)ngt) + 1]; }
#pragma unroll
        for (int u = 0; u < 4; ++u) { u32x4 w; w.x = cvtpk(a[u][0], a[u][1]); w.y = cvtpk(a[u][2], a[u][3]); w.z = cvtpk(b[u][0], b[u][1]); w.w = cvtpk(b[u][2], b[u][3]); ((u32x4*)dst)[i + u * (size_t)ngt] = w; }
    }
    for (; i < n8; i += ngt) {
        const f32x4 a = ((const f32x4*)src)[2 * i], b = ((const f32x4*)src)[2 * i + 1];
        u32x4 w; w.x = cvtpk(a[0], a[1]); w.y = cvtpk(a[2], a[3]); w.z = cvtpk(b[0], b[1]); w.w = cvtpk(b[2], b[3]);
        ((u32x4*)dst)[i] = w;
    }
}

#define XB_TMO      128
#define XB_XCNT(j)  (256  + 64 * (j))
#define XB_XSUB(j)  (1280 + 64 * (j))
#define XB_XGEN(j)  (2304 + 64 * (j))
#define XB_TOP      3328
#define XB_TOPGEN   3392
#define XCD_BAR_WORDS 3456
#define XB_SPIN_CAP (1u << 22)
DI unsigned xb_ld(unsigned* p)              { return __hip_atomic_load(p, __ATOMIC_RELAXED, __HIP_MEMORY_SCOPE_AGENT); }
DI unsigned xb_add(unsigned* p, unsigned v) { return __hip_atomic_fetch_add(p, v, __ATOMIC_RELAXED, __HIP_MEMORY_SCOPE_AGENT); }
DI unsigned xb_xcc_id() { return (unsigned)__builtin_amdgcn_s_getreg((3 << 11) | 20) & 0xFu; }
#define XB_SPIN(cond, bar) do { unsigned _sp = 0; while (cond) { __builtin_amdgcn_s_sleep(1); \
    if ((++_sp & 255u) == 0u) { if (xb_ld(&(bar)[XB_TMO])) break; if (_sp > XB_SPIN_CAP) { atomicAdd(&(bar)[XB_TMO], 1u); break; } } } } while (0)
struct XcdBarrier { unsigned* bar; unsigned x; volatile LAS unsigned* st; };
DI XcdBarrier xcd_barrier_post(unsigned* bar, volatile LAS unsigned* st) {
    XcdBarrier b; b.bar = bar; b.x = xb_xcc_id(); b.st = st;
    if (threadIdx.x == 0) (void)xb_add(&bar[XB_XCNT(b.x)], 1u);
    return b;
}
DI void xcd_barrier_complete(unsigned* bar, unsigned x, unsigned& nloc, unsigned& nx) {
    const unsigned G = gridDim.x * gridDim.y * gridDim.z;
    unsigned sum, cnt, mine, sp = 0u;
    for (;;) {
        sum = 0u; cnt = 0u; mine = 0u;
#pragma unroll
        for (unsigned j = 0; j < 16; ++j) { const unsigned c = xb_ld(&bar[XB_XCNT(j)]); sum += c; cnt += (c > 0u) ? 1u : 0u; mine = (j == x) ? c : mine; }
        if (sum == G) break;
        __builtin_amdgcn_s_sleep(1);
        if ((++sp & 255u) == 0u) { if (xb_ld(&bar[XB_TMO])) break; if (sp > XB_SPIN_CAP) { atomicAdd(&bar[XB_TMO], 1u); break; } }
    }
    nloc = mine > 0u ? mine : 1u; nx = cnt > 0u ? cnt : 1u;
}
DI void xcd_barrier(const XcdBarrier& b) {
    asm volatile("s_waitcnt vmcnt(0)" ::: "memory");
    __syncthreads();
    if (threadIdx.x == 0) {
        unsigned* bar = b.bar;
        __builtin_amdgcn_s_waitcnt(0);
        unsigned nloc = b.st[0], nx = b.st[1];
        if (nloc == 0u) { xcd_barrier_complete(bar, b.x, nloc, nx); b.st[0] = nloc; b.st[1] = nx; }
        const unsigned old = xb_add(&bar[XB_XSUB(b.x)], 1u);
        const unsigned gen = old / nloc;
        if (old + 1u == (gen + 1u) * nloc) {
            __builtin_amdgcn_fence(__ATOMIC_RELEASE, "agent");
            asm volatile("s_waitcnt vmcnt(0)" ::: "memory");
            const unsigned og = xb_add(&bar[XB_TOP], 1u);
            const unsigned tg = og / nx;
            if (og + 1u == (tg + 1u) * nx) xb_add(&bar[XB_TOPGEN], 1u);
            else XB_SPIN(xb_ld(&bar[XB_TOPGEN]) == tg, bar);
            __builtin_amdgcn_fence(__ATOMIC_ACQUIRE, "agent");
            xb_add(&bar[XB_XGEN(b.x)], 1u);
            asm volatile("s_waitcnt vmcnt(0)" ::: "memory");
        } else {
            XB_SPIN(xb_ld(&bar[XB_XGEN(b.x)]) == gen, bar);
            __builtin_amdgcn_fence(__ATOMIC_ACQUIRE, "agent");
            asm volatile("s_waitcnt vmcnt(0)" ::: "memory");
        }
    }
    __syncthreads();
}

struct WDesc { const float* src; bf16_t* dst; int K, N, mode, items; };
struct Params { const float* in[40]; float* out; unsigned char* ws; WDesc w[18]; int ph_lo, ph_hi; };

constexpr int LDS_BYTES = 147456;

__global__ void __launch_bounds__(512, 2) mega_fwd(Params P) {
    extern __shared__ __attribute__((aligned(16))) unsigned char lds_raw[];
    LAS unsigned char* lds = (LAS unsigned char*)lds_raw;
    cg::grid_group grid = cg::this_grid();
    volatile LAS unsigned* bst = (volatile LAS unsigned*)(lds + 131072 + 64);
    if (threadIdx.x == 0) { bst[0] = 0u; bst[1] = 0u; }
    __syncthreads();
    const XcdBarrier xbar = xcd_barrier_post((unsigned*)(P.ws + WS_BAR), bst);
    const int tid0 = threadIdx.x;
    const int G = gridDim.x, bx = blockIdx.x;
    const int ngw = G * 8;
    unsigned char* const ws0 = P.ws;
#define XB ((bf16_t*)(ws + WS_XB))
#define AO ((bf16_t*)(ws + WS_AO))
#define VT ((bf16_t*)(ws + WS_VT))
#define BIG ((bf16_t*)(ws + WS_BIG))
#define KMH ((bf16_t*)(ws + WS_KMH))
#define KML ((bf16_t*)(ws + WS_KML))
#define GWB ((bf16_t*)(ws + WS_GW))
#define MEMB ((bf16_t*)(ws + WS_MEMB))
#define STATS ((f32x2*)(ws + WS_STATS))
#define OUT (P.out)
    int ph = 0;
#define PH_LANE int tid = tid0; asm volatile("" : "+v"(tid)); unsigned char* ws = ws0; asm volatile("" : "+s"(ws)); const int lane = tid & 63, wave = __builtin_amdgcn_readfirstlane(tid >> 6), gw = bx * 8 + wave; (void)lane; (void)gw;
#if MK_ONE_LAUNCH
#define PH_BEGIN { PH_LANE
#define PH_END } xcd_barrier(xbar);
#define PH_END_LAST(last) } if (!(last)) xcd_barrier(xbar);
#define PH_END_CG } if (P.ph_lo > 0x40000000) grid.sync(); xcd_barrier(xbar);
#else
#define PH_BEGIN if (ph >= P.ph_lo && ph < P.ph_hi) { PH_LANE
#define PH_END } { if (ph >= P.ph_lo && ph + 1 < P.ph_hi) grid.sync(); ++ph; }
#define PH_END_CG PH_END
#define PH_END_LAST(last) PH_END
#endif

    PH_BEGIN
    {
        LAS float* scr = (LAS float*)(lds + wave * 8704);
        for (int rep = 0; rep < (PROBE == 5 ? 2 : 1); ++rep) {
        int rot = 0;
#pragma unroll 1
        for (int mi = 0; mi < 18; ++mi) {
            const WDesc d = P.w[mi];
            int v = gw - rot; if (v < 0) v += ngw;
            for (int it = v; it < d.items; it += ngw) transpose_item(d.src, d.K, d.N, d.dst, d.mode, scr, it, lane);
            rot = (rot + d.items) % ngw;
        }
        }
        const int gt = bx * 512 + tid, ngt = G * 512;
        cvt_rows(P.in[0], XB, (size_t)TOK * DM / 8, gt, ngt);
        cvt_rows(P.in[1], MEMB, (size_t)1024 * DM / 8, gt, ngt);
        for (int i = gt; i < TOK; i += ngt) STATS[i] = (f32x2){0.f, 1.f};
        for (int i = gt; i < DM; i += ngt) { ((float*)(ws + WS_LNG))[i] = 1.f; ((float*)(ws + WS_LNB))[i] = 0.f; }
        for (int i = gt; i < 8 * 128 * 128; i += ngt) { const int jj = i & 127, ii = (i >> 7) & 127; GWB[i] = (bf16_t)(cvtpk(jj <= ii ? P.in[9][i] : 0.f, 0.f) & 0xffffu); }
    }
    PH_END_CG

#pragma unroll 1
    for (int l = 0; l < 2; ++l) {
        const float* const* IN = P.in + (l == 0 ? 2 : 23);
        const int o_ln2 = (l == 0 ? 10 : 6);
#define WL (ws + WS_W + l * W_LAYER)
        PH_BEGIN
#if PROBE == 6
        { pg8::Gemm g{XB, (const bf16_t*)(WL + WO_FFN1I), TOK, 2 * DFF, DM}; pg8::StaticOrder S; S.init(TOK, 2 * DFF, G, bx);
          pg8::EpiSwiGLU E{0}; pg8::gemm_phase<pg8::EpiSwiGLU>(lds, g, S, E, tid); }
        asm volatile("" : "+v"(tid));
#endif
        { pg8::Gemm g{XB, (const bf16_t*)(WL + WO_FFN1I), TOK, 2 * DFF, DM}; pg8::StaticOrder S; S.init(TOK, 2 * DFF, G, bx);
          pg8::EpiSwiGLU E{0}; pg8::gemm_phase<pg8::EpiSwiGLU>(lds, g, S, E, tid); }
        { const int nfree = G - (43 * 64) % G;
          if (nfree >= 64 && nfree < G) { if (bx >= G - 64) {
              pg8::Gemm g{MEMB, (const bf16_t*)(WL + WO_MEMKV), 1024, 4096, DM}; pg8::StaticOrder S; S.init(1024, 4096, 64, bx - (G - 64));
              pg8::EpiBf16V E{l};
              pg8::gemm_phase<pg8::EpiBf16V>(lds, g, S, E, tid); } }
          else { pg8::Gemm g{MEMB, (const bf16_t*)(WL + WO_MEMKV), 1024, 4096, DM}; pg8::StaticOrder S; S.init(1024, 4096, G, bx);
              pg8::EpiBf16V E{l};
              pg8::gemm_phase<pg8::EpiBf16V>(lds, g, S, E, tid); } }
        PH_END
        PH_BEGIN
        { pg8::Gemm g{BIG, (const bf16_t*)(WL + WO_FFN1O), TOK, DM, DFF}; pg8::StaticOrder S; S.init(TOK, DM, G, bx);
          pg8::EpiResid E{l == 0 ? 3 : 2}; pg8::gemm_phase<pg8::EpiResid>(lds, g, S, E, tid); }
        PH_END
        PH_BEGIN
        ln_rows(OUT, nullptr, XB, STATS, IN[2], IN[3], gw, ngw, lane);
        PH_END
        PH_BEGIN
        if (l == 0) { pg8::Gemm g{XB, (const bf16_t*)(WL + WO_MIXI), TOK, LD0, DM}; pg8::StaticOrder S; S.init(TOK, LD0, G, bx);
          pg8::EpiBf16V E{2}; pg8::gemm_phase<pg8::EpiBf16V>(lds, g, S, E, tid); }
        else { pg8::Gemm g{XB, (const bf16_t*)(WL + WO_MIXI), TOK, LD1, DM}; pg8::StaticOrder S; S.init(TOK, LD1, G, bx);
          pg8::EpiBf16V E{3}; pg8::gemm_phase<pg8::EpiBf16V>(lds, g, S, E, tid); }
        PH_END
        PH_BEGIN
        if (l == 0) {
#ifndef SKIP_B
            for (int rep = 0; rep < (PROBE == 3 ? 2 : 1); ++rep)
            for (int c = bx; c < 256; c += G) {
                const int ch = c >> 1, g0 = 2 * (c & 1);
                gmlp_unit(ch * 4 + g0, false, BIG, GWB, IN[5], IN[6], IN[8], AO, lds, wave, lane);
                gmlp_unit(ch * 4 + g0 + 1, true, BIG, GWB, IN[5], IN[6], IN[8], AO, lds, wave, lane);
            }
#endif
#ifndef SKIP_A
            for (int rep = 0; rep < (PROBE == 2 ? 2 : 1); ++rep)
            for (int it = gw; it < 4096; it += ngw) mixer_a_item(it, BIG, VT, AO, lane);
#endif
        } else {
            for (int rep = 0; rep < (PROBE == 1 ? 2 : 1); ++rep)
            for (int u = bx; u < 2048; u += G) {
                const int k = u >> 8, v = u & 255, bh = v >> 1, p = v & 1;
                const int n = (k & 1) ? (15 - (k - 1) - p) : (k + p);
                moba_unit(bh >> 5, bh & 31, n, BIG, VT, (const bf16_t*)(ws + WS_KP), KML, AO, lds, tid, wave, lane);
            }
        }
        PH_END
        PH_BEGIN
        { const int Kmix = (l == 0 ? 1536 : 2048);
          pg8::Gemm g{AO, (const bf16_t*)(WL + WO_MIXO), TOK, DM, Kmix}; pg8::StaticOrder S; S.init(TOK, DM, G, bx);
#if PROBE == 7

#endif
          pg8::EpiResid E{0}; pg8::gemm_phase<pg8::EpiResid>(lds, g, S, E, tid); }
        PH_END
        PH_BEGIN
#if PROBE == 8
        ln_rows(OUT, nullptr, BIG, (f32x2*)(BIG + 64 * MiB), IN[o_ln2], IN[o_ln2 + 1], gw, ngw, lane);
#endif
        ln_rows(OUT, nullptr, XB, STATS, IN[o_ln2], IN[o_ln2 + 1], gw, ngw, lane);
        PH_END
        PH_BEGIN
        { pg8::Gemm g{XB, (const bf16_t*)(WL + WO_MEMQ), TOK, DM, DM}; pg8::StaticOrder S; S.init(TOK, DM, G, bx);
          pg8::EpiBf16V E{4}; pg8::gemm_phase<pg8::EpiBf16V>(lds, g, S, E, tid); }
        PH_END
        PH_BEGIN

        for (int u = bx; u < 256; u += G) xattn_unit(u, BIG, (const bf16_t*)(ws + WS_MEMK + l * 4 * MiB), (const bf16_t*)(ws + WS_MEMVT + l * 4 * MiB), AO, lds, tid, wave, lane);
        PH_END
        PH_BEGIN
        { pg8::Gemm g{AO, (const bf16_t*)(WL + WO_MEMO), TOK, DM, DM}; pg8::StaticOrder S; S.init(TOK, DM, G, bx);
          pg8::EpiResid E{0}; pg8::gemm_phase<pg8::EpiResid>(lds, g, S, E, tid); }
        PH_END
        PH_BEGIN
        ln_rows(OUT, nullptr, XB, STATS, IN[o_ln2 + 5], IN[o_ln2 + 6], gw, ngw, lane);
        PH_END
        PH_BEGIN
        { pg8::Gemm g{XB, (const bf16_t*)(WL + WO_FFN2I), TOK, 2 * DFF, DM}; pg8::StaticOrder S; S.init(TOK, 2 * DFF, G, bx);
          pg8::EpiSwiGLU E{0}; pg8::gemm_phase<pg8::EpiSwiGLU>(lds, g, S, E, tid); }
        PH_END
        PH_BEGIN
        { pg8::Gemm g{BIG, (const bf16_t*)(WL + WO_FFN2O), TOK, DM, DFF}; pg8::StaticOrder S; S.init(TOK, DM, G, bx);
          pg8::EpiResid E{2}; pg8::gemm_phase<pg8::EpiResid>(lds, g, S, E, tid); }
        PH_END
        PH_BEGIN
        ln_rows(OUT, l == 1 ? OUT : nullptr, l == 1 ? nullptr : XB, STATS, IN[o_ln2 + 9], IN[o_ln2 + 10], gw, ngw, lane);
        PH_END_LAST(l == 1)
    }
#undef WL
#undef XB
#undef AO
#undef VT
#undef BIG
#undef KMH
#undef KML
#undef GWB
#undef MEMB
#undef STATS
#undef OUT
#undef PH_BEGIN
#undef PH_END
#undef PH_END_CG
#undef PH_END_LAST
}
constexpr int N_PHASES = 1 + 2 * 15;

extern "C" void kernel_launch(void* const* d_in, const int* in_sizes, int n_in, void* d_out, int out_size, void* d_ws, size_t ws_size, hipStream_t stream) {
    static int grid = 0;
    if (grid == 0) {
        if (n_in != 40 || in_sizes[0] != TOK * DM || out_size != TOK * DM || ws_size < WS_END) {
            fprintf(stderr, "kernel_launch: unexpected shapes / workspace (n_in %d, in0 %d, out %d, ws %zu < %zu)\n", n_in, n_in > 0 ? in_sizes[0] : -1, out_size, ws_size, (size_t)WS_END);
            grid = -1; return;
        }
        int dev = 0, cus = 0, per_cu = 0;
        hipGetDevice(&dev);
        hipDeviceGetAttribute(&cus, hipDeviceAttributeMultiprocessorCount, dev);
        if (hipFuncSetAttribute((const void*)mega_fwd, hipFuncAttributeMaxDynamicSharedMemorySize, LDS_BYTES) != hipSuccess) { fprintf(stderr, "kernel_launch: hipFuncSetAttribute failed\n"); grid = -1; return; }
        if (hipOccupancyMaxActiveBlocksPerMultiprocessor(&per_cu, (const void*)mega_fwd, 512, LDS_BYTES) != hipSuccess || per_cu < 1) { fprintf(stderr, "kernel_launch: occupancy query says %d\n", per_cu); per_cu = 1; }
        (void)hipGetLastError();
        grid = cus * (per_cu > 1 ? 1 : per_cu);
        fprintf(stderr, "kernel_launch: grid %d (cus %d, per_cu %d)\n", grid, cus, per_cu);
    }
    if (grid < 0) return;
    Params p{};
    for (int i = 0; i < 40; ++i) p.in[i] = (const float*)d_in[i];
    p.out = (float*)d_out; p.ws = (unsigned char*)d_ws;
    unsigned char* ws = (unsigned char*)d_ws;
    int wi = 0;
    for (int l = 0; l < 2; ++l) {
        const int base = (l == 0 ? 2 : 23);
        const int i_mixi = base + 4, i_mixo = (l == 0 ? base + 9 : base + 5), i_ln2 = (l == 0 ? base + 10 : base + 6);
        unsigned char* WL = ws + WS_W + l * W_LAYER;
        auto add = [&](int idx, size_t off, int K, int N, int mode) { WDesc& d = p.w[wi++]; d.src = (const float*)d_in[idx]; d.dst = (bf16_t*)(WL + off); d.K = K; d.N = N; d.mode = mode; d.items = (K / 64) * (N / 32); };
        add(base + 0, WO_FFN1I, DM, 2 * DFF, 1);
        add(base + 1, WO_FFN1O, DFF, DM, 0);
        add(i_mixi, WO_MIXI, DM, l == 0 ? LD0 : LD1, 0);
        add(i_mixo, WO_MIXO, l == 0 ? 1536 : 2048, DM, 0);
        add(i_ln2 + 2, WO_MEMQ, DM, DM, 0);
        add(i_ln2 + 3, WO_MEMKV, DM, 2 * DM, 0);
        add(i_ln2 + 4, WO_MEMO, DM, DM, 0);
        add(i_ln2 + 7, WO_FFN2I, DM, 2 * DFF, 1);
        add(i_ln2 + 8, WO_FFN2O, DFF, DM, 0);
    }
#if MK_ONE_LAUNCH
    if (hipMemsetAsync(ws + WS_BAR, 0, BAR_BYTES, stream) != hipSuccess) { fprintf(stderr, "kernel_launch: memset failed\n"); return; }
    p.ph_lo = 0; p.ph_hi = N_PHASES;
    void* args[] = {&p};
    hipError_t e = hipLaunchCooperativeKernel((const void*)mega_fwd, dim3(grid), dim3(512), args, LDS_BYTES, stream);
    if (e != hipSuccess) fprintf(stderr, "kernel_launch: cooperative launch failed: %s (grid %d)\n", hipGetErrorString(e), grid);
#else
    for (int ph = 0; ph < N_PHASES; ++ph) {
        p.ph_lo = ph; p.ph_hi = ph + 1;
        hipLaunchKernelGGL(mega_fwd, dim3(grid), dim3(512), LDS_BYTES, stream, p);
    }
#endif
}
```

```cpp
#include <hip/hip_runtime.h>
#include <hip/hip_cooperative_groups.h>
#include <cstdio>
#include <cstdint>
namespace cg = cooperative_groups;

#ifndef PROBE
#define PROBE 0
#endif
#ifndef MK_ONE_LAUNCH
#define MK_ONE_LAUNCH 1
#endif

#define DI __device__ __forceinline__
#define LAS __attribute__((address_space(3)))
typedef unsigned short bf16_t;
typedef short bf16x8 __attribute__((ext_vector_type(8)));
typedef float f32x4 __attribute__((ext_vector_type(4)));
typedef float f32x2 __attribute__((ext_vector_type(2)));
typedef float f32x16 __attribute__((ext_vector_type(16)));
typedef unsigned u32x4 __attribute__((ext_vector_type(4)));
typedef unsigned u32x2 __attribute__((ext_vector_type(2)));
typedef __bf16 bf16x2_t __attribute__((ext_vector_type(2)));

DI unsigned cvtpk(float lo, float hi) { f32x2 v = {lo, hi}; bf16x2_t b = __builtin_convertvector(v, bf16x2_t); return __builtin_bit_cast(unsigned, b); }
DI float bflo(unsigned w) { return __uint_as_float(w << 16); }
DI float bfhi(unsigned w) { return __uint_as_float(w & 0xffff0000u); }
DI float fexp2(float x) { return __builtin_amdgcn_exp2f(x); }
DI float frcp(float x) { return __builtin_amdgcn_rcpf(x); }
DI float wave_sum(float v) {
#pragma unroll
    for (int o = 1; o < 64; o <<= 1) v += __shfl_xor(v, o);
    return v;
}
DI float gelu_t(float x) { const float z = 1.5957691216057308f * (x + 0.044715f * x * x * x); return x * frcp(1.0f + fexp2(-1.4426950408889634f * z)); }
DI float silu_f(float x) { return x * frcp(1.0f + fexp2(-1.4426950408889634f * x)); }

constexpr int TOK = 16384, DM = 2048, DFF = 5504, SEQ = 4096;
constexpr int LD0 = 6656, LD1 = 6144;
constexpr float LN_EPS = 1e-5f;
constexpr float ALPHA = 1.4142135623730951f;

constexpr size_t MiB = 1u << 20;
constexpr size_t WS_KMH = 0, WS_KML = 256 * 1024, WS_GW = 512 * 1024, WS_BAR = 1024 * 1024, BAR_BYTES = 16384, WS_STATS = 768 * 1024, WS_LNG = 896 * 1024, WS_LNB = 904 * 1024;
constexpr size_t WS_MEMB = 2 * MiB, WS_MEMK = 6 * MiB  , WS_MEMVT = 14 * MiB  ;
constexpr size_t WS_W = 22 * MiB, W_LAYER = 195 * MiB;
constexpr size_t WO_FFN1I = 0, WO_FFN1O = 43 * MiB, WO_MIXI = 64 * MiB + MiB / 2, WO_MIXO = 90 * MiB + MiB / 2, WO_MEMQ = 98 * MiB + MiB / 2,
                 WO_MEMKV = 106 * MiB + MiB / 2, WO_MEMO = 122 * MiB + MiB / 2, WO_FFN2I = 130 * MiB + MiB / 2, WO_FFN2O = 173 * MiB + MiB / 2;
constexpr size_t WS_XB = 412 * MiB, WS_AO = 476 * MiB, WS_VT = 540 * MiB, WS_BIG = 604 * MiB, WS_KP = 812 * MiB, WS_END = 813 * MiB;

typedef const char __attribute__((address_space(4)))* kargp_t;
DI kargp_t karg_base() { kargp_t p = (kargp_t)__builtin_amdgcn_kernarg_segment_ptr(); asm volatile("" : "+s"(p)); return p; }
DI const float* karg_in(kargp_t p, int i) { return *(const float* const __attribute__((address_space(4)))*)(p + 8 * i); }
DI float* karg_out(kargp_t p) { return *(float* const __attribute__((address_space(4)))*)(p + 320); }
DI unsigned char* karg_ws(kargp_t p) { return *(unsigned char* const __attribute__((address_space(4)))*)(p + 328); }

namespace pg8 {
constexpr int BM = 256, BK = 64, HALF = 128, HTB = HALF * BK * 2, STAGE_BYTES = 8 * HTB, NXCD = 8, WGM = 4;
DI int lds_byte(int r, int c) { const int st = (r >> 4) * 2 + (c >> 5), rr = r & 15, cc = c & 31, ob = rr * 64 + cc * 2; return st * 1024 + (ob ^ (((ob >> 9) & 1) << 5)); }
DI void stage_rc(int b, int& R, int& C) { const int st = b / 1024, sb = b % 1024, swz = sb ^ (((sb >> 9) & 1) << 5); R = (st >> 1) * 16 + swz / 64; C = (st & 1) * 32 + (swz % 64) / 2; }
DI int perm32(int rho) { const int n = rho >> 4, i = rho & 15; return 8 * (i >> 2) + 4 * n + (i & 3); }

struct Unit { int pm, pn; };
struct Gemm { const bf16_t* A; const bf16_t* Bt; int M, N, K; };

struct StaticOrder {
    int nM, nN, nwg, G, c;
    DI void init(int M, int N, int G_, int c_) { nM = M / BM; nN = N / BM; nwg = nM * nN; G = G_; c = c_; }
    DI bool next(int i, Unit& u) const {
        const long L = (long)i * G + c; if (L >= nwg) return false;
        int wgid = (int)L; { const int q = nwg / NXCD, r = nwg % NXCD, xcd = wgid % NXCD, off = wgid / NXCD; wgid = (xcd < r ? xcd * (q + 1) : r * (q + 1) + (xcd - r) * q) + off; }
        const int nig = WGM * nN, gid = wgid / nig, fm = gid * WGM, gsz = (nM - fm) < WGM ? (nM - fm) : WGM;
        u.pm = fm + ((wgid % nig) % gsz); u.pn = (wgid % nig) / gsz; return true;
    }
};


struct EpiSwiGLU {
    static constexpr bool PERM = true;
    int dummy;
    DI void operator()(const f32x4 (&acc)[2][2][4][2], const Unit& u, int wr, int wc, int fr, int fq) const {
        bf16_t* H = (bf16_t*)(karg_ws(karg_base()) + WS_BIG);
        int row0 = u.pm * BM + wr * 64 + fr, col0 = u.pn * HALF + wc * 32 + 8 * fq;
        asm volatile("" : "+v"(row0), "+v"(col0));
#pragma unroll
        for (int ai = 0; ai < 2; ++ai)
#pragma unroll
            for (int m = 0; m < 4; ++m) {
                bf16_t* rowp = H + (size_t)(row0 + ai * HALF + m * 16) * DFF + col0;
                const f32x4 g0 = acc[ai][0][m][0], g1 = acc[ai][0][m][1], u0 = acc[ai][1][m][0], u1 = acc[ai][1][m][1];
                u32x4 w;
#define SWG(g, u) ((g) * (u) * frcp(1.0f + fexp2(-(g))))
                w.x = cvtpk(SWG(g0[0], u0[0]), SWG(g0[1], u0[1])); w.y = cvtpk(SWG(g0[2], u0[2]), SWG(g0[3], u0[3]));
                w.z = cvtpk(SWG(g1[0], u1[0]), SWG(g1[1], u1[1])); w.w = cvtpk(SWG(g1[2], u1[2]), SWG(g1[3], u1[3]));
#undef SWG
                *(u32x4*)rowp = w;
            }
    }
};
struct EpiResid {
    static constexpr bool PERM = true;
    int flags;
    DI void operator()(const f32x4 (&acc)[2][2][4][2], const Unit& u, int wr, int wc, int fr, int fq) const {
        int row0 = u.pm * BM + wr * 64 + fr, col0 = u.pn * BM + wc * 32 + 8 * fq;
        asm volatile("" : "+v"(row0), "+v"(col0));
        const kargp_t ka = karg_base();
        float* Y = karg_out(ka);
        const float* R = (flags & 1) ? karg_in(ka, 0) : (const float*)Y;
        const unsigned char* wsl = karg_ws(ka);
        const f32x2* stats = (const f32x2*)(wsl + WS_STATS);
        const float scale = (flags & 2) ? 0.5f : 1.0f;
#pragma unroll
        for (int bj = 0; bj < 2; ++bj) {
            int cc = col0 + bj * HALF;
            asm volatile("" : "+v"(cc));
            const f32x4 g0 = *(const f32x4*)((const float*)(wsl + WS_LNG) + cc), g1 = *(const f32x4*)((const float*)(wsl + WS_LNG) + cc + 4);
            const f32x4 b0 = *(const f32x4*)((const float*)(wsl + WS_LNB) + cc), b1 = *(const f32x4*)((const float*)(wsl + WS_LNB) + cc + 4);
#pragma unroll
            for (int ai = 0; ai < 2; ++ai)
#pragma unroll
                for (int m = 0; m < 4; ++m) {
                    const int row = row0 + ai * HALF + m * 16;
                    const f32x2 st = stats[row];
                    const size_t off = (size_t)row * DM + cc;
                    const f32x4 r0 = *(const f32x4*)(R + off), r1 = *(const f32x4*)(R + off + 4);
                    const f32x4 x0 = (r0 - st[0]) * st[1] * g0 + b0, x1 = (r1 - st[0]) * st[1] * g1 + b1;
                    *(f32x4*)(Y + off) = x0 * ALPHA + acc[ai][bj][m][0] * scale;
                    *(f32x4*)(Y + off + 4) = x1 * ALPHA + acc[ai][bj][m][1] * scale;
                }
        }
    }
};
struct EpiBf16V {
    static constexpr bool PERM = true;
    int kind;
    DI void operator()(const f32x4 (&acc)[2][2][4][2], const Unit& u, int wr, int wc, int fr, int fq) const {
        unsigned char* wsl = karg_ws(karg_base());
        bf16_t* O; bf16_t* VT; int ldc, vt_lo, vt_hi, NH, hd_sh, ls, dilated;
        if (kind < 2)       { O = (bf16_t*)(wsl + WS_MEMK + kind * 4 * MiB); VT = (bf16_t*)(wsl + WS_MEMVT + kind * 4 * MiB); ldc = DM; vt_lo = 8; vt_hi = 16; NH = 4; hd_sh = 9; ls = 8; dilated = 0; }
        else if (kind == 2) { O = (bf16_t*)(wsl + WS_BIG); VT = (bf16_t*)(wsl + WS_VT); ldc = LD0; vt_lo = 12; vt_hi = 18; NH = 24; hd_sh = 6; ls = 12; dilated = 1; }
        else if (kind == 3) { O = (bf16_t*)(wsl + WS_BIG); VT = (bf16_t*)(wsl + WS_VT); ldc = LD1; vt_lo = 16; vt_hi = 24; NH = 32; hd_sh = 6; ls = 12; dilated = 0; }
        else if (kind == 4) { O = (bf16_t*)(wsl + WS_BIG); VT = (bf16_t*)(wsl + WS_VT); ldc = DM; vt_lo = 0; vt_hi = 0; NH = 1; hd_sh = 6; ls = 12; dilated = 0; }
        else                { O = (bf16_t*)(wsl + WS_VT) + (size_t)(u.pn >> 4) * ((size_t)2048 * 4096); VT = O; ldc = 4096; vt_lo = 0; vt_hi = 0; NH = 1; hd_sh = 6; ls = 12; dilated = 0; }
        const int pn_eff = (kind == 5) ? (u.pn & 15) : u.pn;
        int row0 = u.pm * BM + wr * 64 + fr; int fq8 = 8 * fq;
        asm volatile("" : "+v"(row0), "+v"(fq8));
        if (u.pn >= vt_lo && u.pn < vt_hi) {
#pragma unroll
            for (int bj = 0; bj < 2; ++bj) {
                const int vc0 = (u.pn - vt_lo) * BM + bj * HALF + wc * 32 + fq8;
                const int head = vc0 >> hd_sh, d0 = vc0 & ((1 << hd_sh) - 1);
                const int sh = dilated ? 2 * (head >> 3) : 0;
                if (sh == 4) {
#pragma unroll
                    for (int ai = 0; ai < 2; ++ai) {
                        const int row = row0 + ai * HALF;
                        const int b = row >> ls, t = row & ((1 << ls) - 1);
                        const int pos = ((t & 15) << (ls - 4)) | (t >> 4);
                        bf16_t* p = VT + ((((size_t)(b * NH + head) << hd_sh) + d0) << ls) + pos;
#pragma unroll
                        for (int e = 0; e < 8; ++e) {
                            u32x2 w; w.x = cvtpk(acc[ai][bj][0][e >> 2][e & 3], acc[ai][bj][1][e >> 2][e & 3]); w.y = cvtpk(acc[ai][bj][2][e >> 2][e & 3], acc[ai][bj][3][e >> 2][e & 3]);
                            *(u32x2*)(p + ((size_t)e << ls)) = w;
                        }
                    }
                } else
#pragma unroll
                for (int ai = 0; ai < 2; ++ai)
#pragma unroll
                    for (int m = 0; m < 4; ++m) {
                        const int row = row0 + ai * HALF + m * 16;
                        const int b = row >> ls, t = row & ((1 << ls) - 1);
                        const int pos = ((t & ((1 << sh) - 1)) << (ls - sh)) | (t >> sh);
                        bf16_t* p = VT + ((((size_t)(b * NH + head) << hd_sh) + d0) << ls) + pos;
#pragma unroll
                        for (int e = 0; e < 8; ++e) p[(size_t)e << ls] = (bf16_t)(cvtpk(acc[ai][bj][m][e >> 2][e & 3], 0.f) & 0xffffu);
                    }
            }
        } else {
            if (kind == 3 && u.pn >= 8) {
                float* kp = (float*)(wsl + WS_KP) + ((size_t)(u.pm * 2 + wr) * 2048) + (u.pn - 8) * BM + wc * 32 + fq8;
#pragma unroll
                for (int bj = 0; bj < 2; ++bj)
#pragma unroll
                    for (int n = 0; n < 2; ++n) {
                        f32x4 cs = (f32x4){0.f, 0.f, 0.f, 0.f};
#pragma unroll
                        for (int ai = 0; ai < 2; ++ai)
#pragma unroll
                            for (int m = 0; m < 4; ++m) cs += acc[ai][bj][m][n];
#pragma unroll
                        for (int e = 0; e < 4; ++e) { float v = cs[e]; v += __shfl_xor(v, 1); v += __shfl_xor(v, 2); v += __shfl_xor(v, 4); v += __shfl_xor(v, 8); cs[e] = v; }
                        if (fr == 0) *(f32x4*)(kp + bj * HALF + 4 * n) = cs;
                    }
            }
            const int col0 = pn_eff * BM + wc * 32 + fq8;
#pragma unroll
            for (int ai = 0; ai < 2; ++ai)
#pragma unroll
                for (int m = 0; m < 4; ++m) {
                    bf16_t* rowp = O + (size_t)(row0 + ai * HALF + m * 16) * ldc + col0;
#pragma unroll
                    for (int bj = 0; bj < 2; ++bj) {
                        const f32x4 v0 = acc[ai][bj][m][0], v1 = acc[ai][bj][m][1];
                        u32x4 w; w.x = cvtpk(v0[0], v0[1]); w.y = cvtpk(v0[2], v0[3]); w.z = cvtpk(v1[0], v1[1]); w.w = cvtpk(v1[2], v1[3]);
                        *(u32x4*)(rowp + bj * HALF) = w;
                    }
                }
        }
    }
};

template <class Epi>
DI void gemm_phase(LAS unsigned char* lds, const Gemm g, const StaticOrder& S, const Epi& E, const int tid) {
    const int wid = __builtin_amdgcn_readfirstlane(tid >> 6), lane = tid & 63, wr = wid >> 2, wc = wid & 3, fr = lane & 15, fq = lane >> 4;
    const int K = g.K, nt = K / BK;
    unsigned voffA[2], voffB[2];
#pragma unroll
    for (int i = 0; i < 2; ++i) { int R, C; stage_rc(tid * 16 + i * 8192, R, C); const int Rb = Epi::PERM ? ((R & ~31) + perm32(R & 31)) : R;
        voffA[i] = (unsigned)(R * K + C) * 2u; voffB[i] = (unsigned)(Rb * K + C) * 2u; }
    const size_t kstep = (size_t)(BK * 2);
    const size_t hstep = (size_t)HALF * K * 2;
    const size_t tstep = 2 * hstep;
    const unsigned ldsw = (unsigned)wid * 1024u;
    const int aoff = lds_byte(wr * 64 + fr, fq * 8), boff = lds_byte(wc * 32 + fr, fq * 8);
#define PG8_SA(b, h) (((b) * 2 + (h)) * HTB)
#define PG8_SB(b, h) ((4 + (b) * 2 + (h)) * HTB)
#define PG8_STAGE(bufoff, gbase, voff) do { _Pragma("unroll") for (int _i = 0; _i < 2; ++_i) \
        __builtin_amdgcn_global_load_lds((const unsigned*)((const char*)(gbase) + (voff)[_i]), (LAS unsigned*)(lds + (bufoff) + ldsw + _i * 8192), 16, 0, 0); } while (0)
#define PG8_LDA(dst, b, h) do { _Pragma("unroll") for (int m = 0; m < 4; ++m) _Pragma("unroll") for (int k = 0; k < 2; ++k) dst[m][k] = *(const LAS bf16x8*)(lds + PG8_SA(b, h) + aoff + m * 2048 + k * 1024); } while (0)
#define PG8_LDB(dst, b, h) do { _Pragma("unroll") for (int n = 0; n < 2; ++n) _Pragma("unroll") for (int k = 0; k < 2; ++k) dst[n][k] = *(const LAS bf16x8*)(lds + PG8_SB(b, h) + boff + n * 2048 + k * 1024); } while (0)
#define PG8_MMA(ai, bj, At, Bt) do { __builtin_amdgcn_s_setprio(1); _Pragma("unroll") for (int m = 0; m < 4; ++m) _Pragma("unroll") for (int n = 0; n < 2; ++n) _Pragma("unroll") for (int k = 0; k < 2; ++k) \
        acc[ai][bj][m][n] = __builtin_amdgcn_mfma_f32_16x16x32_bf16(Bt[n][k], At[m][k], acc[ai][bj][m][n], 0, 0, 0); __builtin_amdgcn_s_setprio(0); } while (0)
#define PG8_WAIT_V(n) asm volatile("s_waitcnt vmcnt(" #n ")" ::: "memory")
#define PG8_WAIT_L(n) asm volatile("s_waitcnt lgkmcnt(" #n ")" ::: "memory")
#define PG8_BAR __builtin_amdgcn_s_barrier()
#define PG8_SCHED __builtin_amdgcn_sched_barrier(0)
    Unit cur, nxt; int ui = 0;
    if (!S.next(0, cur)) return;
    f32x4 acc[2][2][4][2];
#pragma unroll
    for (int a = 0; a < 2; ++a)
#pragma unroll
        for (int b = 0; b < 2; ++b)
#pragma unroll
            for (int m = 0; m < 4; ++m)
#pragma unroll
                for (int n = 0; n < 2; ++n) acc[a][b][m][n] = (f32x4){0.f, 0.f, 0.f, 0.f};
    bf16x8 At[4][2], B0[2][2], B1[2][2];
    const char* cA = (const char*)g.A + (size_t)cur.pm * tstep; const char* cB = (const char*)g.Bt + (size_t)cur.pn * tstep;
    PG8_STAGE(PG8_SB(0, 0), cB, voffB); PG8_STAGE(PG8_SB(0, 1), cB + hstep, voffB); PG8_STAGE(PG8_SA(0, 0), cA, voffA); PG8_STAGE(PG8_SA(0, 1), cA + hstep, voffA);
    if (wr == 1) PG8_BAR;
    PG8_WAIT_V(2); PG8_BAR;
    PG8_STAGE(PG8_SB(1, 0), cB + kstep, voffB); PG8_STAGE(PG8_SA(1, 0), cA + kstep, voffA); PG8_STAGE(PG8_SB(1, 1), cB + hstep + kstep, voffB);
    PG8_WAIT_V(6); PG8_BAR;
    for (;;) {
        const bool has_next = S.next(ui + 1, nxt);
        const char* nA = has_next ? (const char*)g.A + (size_t)nxt.pm * tstep : cA; const char* nB = has_next ? (const char*)g.Bt + (size_t)nxt.pn * tstep : cB;
        for (int t = 0; t < nt; t += 2) {
            const bool last = (t == nt - 2);
            const char* a1 = cA + (size_t)(t + 1) * kstep;
            const char* a2 = last ? nA : cA + (size_t)(t + 2) * kstep; const char* b2 = last ? nB : cB + (size_t)(t + 2) * kstep;
            const char* a3 = a2 + kstep; const char* b3 = b2 + kstep;
            PG8_LDB(B0, 0, 0); PG8_LDB(B1, 0, 1); PG8_SCHED; PG8_LDA(At, 0, 0); PG8_STAGE(PG8_SA(1, 1), a1 + hstep, voffA);
            PG8_WAIT_V(8); PG8_WAIT_L(0); PG8_BAR; PG8_MMA(0, 0, At, B0); PG8_MMA(0, 1, At, B1); PG8_BAR; PG8_SCHED;
            PG8_LDA(At, 0, 1); PG8_STAGE(PG8_SB(0, 0), b2, voffB); PG8_STAGE(PG8_SB(0, 1), b2 + hstep, voffB); PG8_STAGE(PG8_SA(0, 0), a2, voffA);
            PG8_WAIT_V(8); PG8_WAIT_L(0); PG8_BAR; PG8_MMA(1, 0, At, B0); PG8_MMA(1, 1, At, B1); PG8_BAR; PG8_SCHED;
            PG8_LDB(B0, 1, 0); PG8_LDB(B1, 1, 1); PG8_SCHED; PG8_LDA(At, 1, 0); PG8_STAGE(PG8_SA(0, 1), a2 + hstep, voffA);
            PG8_WAIT_V(8); PG8_WAIT_L(0); PG8_BAR; PG8_MMA(0, 0, At, B0); PG8_MMA(0, 1, At, B1); PG8_BAR; PG8_SCHED;
            PG8_LDA(At, 1, 1); PG8_STAGE(PG8_SB(1, 0), b3, voffB); PG8_STAGE(PG8_SB(1, 1), b3 + hstep, voffB); PG8_STAGE(PG8_SA(1, 0), a3, voffA);
            PG8_WAIT_V(8); PG8_WAIT_L(0); PG8_BAR; PG8_MMA(1, 0, At, B0); PG8_MMA(1, 1, At, B1); PG8_BAR; PG8_SCHED;
        }
        if (wr == 0) PG8_BAR;
        E(acc, cur, wr, wc, fr, fq);
        if (!has_next) break;
#pragma unroll
        for (int a = 0; a < 2; ++a)
#pragma unroll
            for (int b = 0; b < 2; ++b)
#pragma unroll
                for (int m = 0; m < 4; ++m)
#pragma unroll
                    for (int n = 0; n < 2; ++n) acc[a][b][m][n] = (f32x4){0.f, 0.f, 0.f, 0.f};
        cur = nxt; cA = nA; cB = nB; ++ui;
        if (wr == 1) PG8_BAR;
    }
    PG8_WAIT_V(0);
    PG8_BAR;
#undef PG8_SA
#undef PG8_SB
#undef PG8_STAGE
#undef PG8_LDA
#undef PG8_LDB
#undef PG8_MMA
#undef PG8_WAIT_V
#undef PG8_WAIT_L
#undef PG8_BAR
#undef PG8_SCHED
}
}

#define MFMA32(a, b, c) __builtin_amdgcn_mfma_f32_32x32x16_bf16((a), (b), (c), 0, 0, 0)
DI int pi32(int rho) { return (rho & ~12) | ((rho & 4) << 1) | ((rho & 8) >> 1); }
DI int kofs(int i, int h) { return 16 * (i >> 3) + 8 * h + (i & 7); }
DI float xhalf_max(float m) { auto rr = __builtin_amdgcn_permlane32_swap(__float_as_uint(m), __float_as_uint(m), false, false); return fmaxf(__uint_as_float(rr[0]), __uint_as_float(rr[1])); }
DI bf16x8 pack8(const f32x16& p, int s) {
    u32x4 w; w.x = cvtpk(p[8 * s], p[8 * s + 1]); w.y = cvtpk(p[8 * s + 2], p[8 * s + 3]); w.z = cvtpk(p[8 * s + 4], p[8 * s + 5]); w.w = cvtpk(p[8 * s + 6], p[8 * s + 7]);
    return __builtin_bit_cast(bf16x8, w);
}
DI void softmax_pv(const f32x16& s, float& m_run, float& l_run, f32x16& o0, f32x16& o1, bf16x8 v00, bf16x8 v01, bf16x8 v10, bf16x8 v11) {
    float mx = s[0];
#pragma unroll
    for (int i = 1; i < 16; ++i) mx = fmaxf(mx, s[i]);
    mx = xhalf_max(mx);
    const float mnew = fmaxf(m_run, mx);
    const float alpha = fexp2(m_run - mnew);
    m_run = mnew;
    f32x16 p; float sum = 0.f;
#pragma unroll
    for (int i = 0; i < 16; ++i) { p[i] = fexp2(s[i] - mnew); sum += p[i]; }
    l_run = l_run * alpha + sum;
    if (__any(alpha != 1.0f)) { o0 = o0 * alpha; o1 = o1 * alpha; }
    const bf16x8 pb0 = pack8(p, 0), pb1 = pack8(p, 1);
    o0 = MFMA32(v00, pb0, o0); o0 = MFMA32(v01, pb1, o0);
    o1 = MFMA32(v10, pb0, o1); o1 = MFMA32(v11, pb1, o1);
}
DI void store_o64(bf16_t* orow, const f32x16& o0, const f32x16& o1, float inv, int h) {
#pragma unroll
    for (int g4 = 0; g4 < 4; ++g4) {
        u32x2 w0, w1;
        w0.x = cvtpk(o0[4 * g4] * inv, o0[4 * g4 + 1] * inv); w0.y = cvtpk(o0[4 * g4 + 2] * inv, o0[4 * g4 + 3] * inv);
        w1.x = cvtpk(o1[4 * g4] * inv, o1[4 * g4 + 1] * inv); w1.y = cvtpk(o1[4 * g4 + 2] * inv, o1[4 * g4 + 3] * inv);
        *(u32x2*)(orow + 8 * g4 + 4 * h) = w0;
        *(u32x2*)(orow + 32 + 8 * g4 + 4 * h) = w1;
    }
}

DI void mixer_a_item(int item, const bf16_t* QKV, const bf16_t* VT, bf16_t* AO, int lane) {
    const int qs = item & 7, r = (item >> 3) & 15, j = (item >> 7) & 7, b = item >> 10;
    const int ql = lane & 31, h = lane >> 5;
    const float C = 0.125f * 1.4426950408889634f;
    const int tq = 16 * (32 * qs + ql) + r;
    float m_run = -1e30f, l_run = 0.f; f32x16 o0, o1;
#pragma unroll
    for (int i = 0; i < 16; ++i) { o0[i] = 0.f; o1[i] = 0.f; }
#pragma unroll 1
    for (int g = 0; g < 3; ++g) {
        const int sh = 2 * g, dil = 1 << sh, Lg = SEQ >> sh, head = 8 * g + j, rg = r & (dil - 1);
        const int mq = tq >> sh, mq_min = (512 * qs + r) >> sh, mq_max = (16 * (32 * qs + 31) + r) >> sh;
        int klo = mq_min - 128; klo = klo < 0 ? 0 : klo; klo &= ~31;
        const bf16_t* qp = QKV + (size_t)(b * SEQ + tq) * LD0 + head * 64 + 8 * h;
        bf16x8 qf[4];
#pragma unroll
        for (int jj = 0; jj < 4; ++jj) qf[jj] = *(const bf16x8*)(qp + 16 * jj);
        const bf16_t* kbase = QKV + (size_t)(b * SEQ + rg) * LD0 + 1536 + head * 64 + 8 * h;
        const bf16_t* vbase = VT + ((size_t)((b * 24 + head) * 64 + ql) << 12) + rg * Lg + 8 * h;
#pragma unroll 1
        for (int kt = klo; kt <= mq_max; kt += 32) {
            const bf16_t* kp = kbase + (size_t)((kt + pi32(ql)) << sh) * LD0;
            bf16x8 kf[4];
#pragma unroll
            for (int jj = 0; jj < 4; ++jj) kf[jj] = *(const bf16x8*)(kp + 16 * jj);
            const bf16_t* vp = vbase + kt;
            const bf16x8 v00 = *(const bf16x8*)(vp), v01 = *(const bf16x8*)(vp + 16);
            const bf16x8 v10 = *(const bf16x8*)(vp + ((size_t)32 << 12)), v11 = *(const bf16x8*)(vp + ((size_t)32 << 12) + 16);
            f32x16 s;
#pragma unroll
            for (int i = 0; i < 16; ++i) s[i] = 0.f;
#pragma unroll
            for (int jj = 0; jj < 4; ++jj) s = MFMA32(kf[jj], qf[jj], s);
#pragma unroll
            for (int i = 0; i < 16; ++i) { const int dist = mq - (kt + kofs(i, h)); s[i] = (dist >= 0 && dist <= 128) ? s[i] * C : -INFINITY; }
            softmax_pv(s, m_run, l_run, o0, o1, v00, v01, v10, v11);
        }
    }
    const float l = l_run + __shfl_xor(l_run, 32);
    store_o64(AO + (size_t)(b * SEQ + tq) * 1536 + j * 64, o0, o1, 1.0f / l, h);
}

DI void gmlp_unit(int unit, bool reuse, const bf16_t* QKV, const bf16_t* Wb, const float* lng, const float* lnb, const float* bs, bf16_t* AO,
                  LAS unsigned char* lds, int wave, int lane) {
    const int gp = unit & 3, n = (unit >> 2) & 31, b = unit >> 7;
    LAS f32x2* STl = (LAS f32x2*)(lds + 69632);
    LAS bf16_t* VTl = (LAS bf16_t*)lds;
    const size_t row0 = (size_t)b * SEQ + 128 * n;
    const f32x4 gam = *(const f32x4*)(lng + 256 * gp + 4 * lane), bet = *(const f32x4*)(lnb + 256 * gp + 4 * lane);
#pragma unroll 4
    for (int tt = 0; tt < 16; ++tt) {
        const int tok = 16 * wave + tt;
        const bf16_t* vr = QKV + (row0 + tok) * LD0 + 5632;
        float mean, rstd;
        if (!reuse) {
            const u32x4 a = *(const u32x4*)(vr + 8 * lane), c = *(const u32x4*)(vr + 512 + 8 * lane);
            float x[16];
#pragma unroll
            for (int e = 0; e < 4; ++e) { x[2 * e] = gelu_t(bflo(a[e])); x[2 * e + 1] = gelu_t(bfhi(a[e])); x[8 + 2 * e] = gelu_t(bflo(c[e])); x[9 + 2 * e] = gelu_t(bfhi(c[e])); }
            float s = 0.f;
#pragma unroll
            for (int e = 0; e < 16; ++e) s += x[e];
            mean = wave_sum(s) * (1.0f / 1024.0f);
            float s2 = 0.f;
#pragma unroll
            for (int e = 0; e < 16; ++e) { const float d = x[e] - mean; s2 += d * d; }
            rstd = 1.0f / sqrtf(wave_sum(s2) * (1.0f / 1024.0f) + LN_EPS);
            if (lane == 0) STl[tok] = (f32x2){mean, rstd};
        } else { const f32x2 st = STl[tok]; mean = st[0]; rstd = st[1]; }
        const u32x2 raw = *(const u32x2*)(vr + 256 * gp + 4 * lane);
        const float y0 = (gelu_t(bflo(raw.x)) - mean) * rstd * gam[0] + bet[0], y1 = (gelu_t(bfhi(raw.x)) - mean) * rstd * gam[1] + bet[1];
        const float y2 = (gelu_t(bflo(raw.y)) - mean) * rstd * gam[2] + bet[2], y3 = (gelu_t(bfhi(raw.y)) - mean) * rstd * gam[3] + bet[3];
        const unsigned w01 = cvtpk(y0, y1), w23 = cvtpk(y2, y3);
        VTl[(4 * lane + 0) * 136 + tok] = (bf16_t)(w01 & 0xffffu); VTl[(4 * lane + 1) * 136 + tok] = (bf16_t)(w01 >> 16);
        VTl[(4 * lane + 2) * 136 + tok] = (bf16_t)(w23 & 0xffffu); VTl[(4 * lane + 3) * 136 + tok] = (bf16_t)(w23 >> 16);
    }
    __syncthreads();
    {
        const int ql = lane & 31, h = lane >> 5, g = 2 * gp + (wave >> 2);
        const LAS bf16_t* arow = VTl + (32 * wave + ql) * 136 + 8 * h;
#pragma unroll 1
        for (int it = 0; it < 4; ++it) {
            const int i = 32 * it + ql;
            const bf16_t* wrow = Wb + ((size_t)g * 128 + i) * 128 + 8 * h;
            f32x16 acc;
#pragma unroll
            for (int e = 0; e < 16; ++e) acc[e] = 0.f;
#pragma unroll 2
            for (int js = 0; js <= 2 * it + 1; ++js) {
                const bf16x8 af = *(const LAS bf16x8*)(arow + 16 * js);
                const bf16x8 bfr = *(const bf16x8*)(wrow + 16 * js);
                acc = MFMA32(af, bfr, acc);
            }
            const float bias = bs[g * 128 + i];
            const bf16_t* urow = QKV + (row0 + i) * LD0 + 4608 + 256 * gp + 32 * wave + 4 * h;
            bf16_t* orow = AO + (row0 + i) * 1536 + 512 + 256 * gp + 32 * wave + 4 * h;
#pragma unroll
            for (int qd = 0; qd < 4; ++qd) {
                const u32x2 uu = *(const u32x2*)(urow + 8 * qd);
                u32x2 w;
                w.x = cvtpk(gelu_t(bflo(uu.x)) * (acc[4 * qd] + bias), gelu_t(bfhi(uu.x)) * (acc[4 * qd + 1] + bias));
                w.y = cvtpk(gelu_t(bflo(uu.y)) * (acc[4 * qd + 2] + bias), gelu_t(bfhi(uu.y)) * (acc[4 * qd + 3] + bias));
                *(u32x2*)(orow + 8 * qd) = w;
            }
        }
    }
    __syncthreads();
}

DI void kmean_item(int item, const bf16_t* QKV, bf16_t* KMH, bf16_t* KML, int lane) {
    const int blk = item & 15, hh = (item >> 4) & 31, b = item >> 9;
    const int dc = lane & 7, rgp = lane >> 3;
    const bf16_t* kp = QKV + (size_t)(b * SEQ + 256 * blk + rgp) * LD1 + 2048 + hh * 64 + 8 * dc;
    float s[8];
#pragma unroll
    for (int e = 0; e < 8; ++e) s[e] = 0.f;
#pragma unroll 8
    for (int i = 0; i < 32; ++i) {
        const u32x4 v = *(const u32x4*)(kp + (size_t)(8 * i) * LD1);
#pragma unroll
        for (int e = 0; e < 4; ++e) { s[2 * e] += bflo(v[e]); s[2 * e + 1] += bfhi(v[e]); }
    }
#pragma unroll
    for (int e = 0; e < 8; ++e) { s[e] += __shfl_xor(s[e], 8); s[e] += __shfl_xor(s[e], 16); s[e] += __shfl_xor(s[e], 32); s[e] *= (1.0f / 256.0f); }
    if (rgp == 0) {
        u32x4 hi, lo;
#pragma unroll
        for (int e = 0; e < 4; ++e) {
            const unsigned hw = cvtpk(s[2 * e], s[2 * e + 1]); hi[e] = hw;
            lo[e] = cvtpk(s[2 * e] - bflo(hw), s[2 * e + 1] - bfhi(hw));
        }
        const size_t o = (size_t)item * 64 + 8 * dc;
        *(u32x4*)(KMH + o) = hi; *(u32x4*)(KML + o) = lo;
    }
}

DI void moba_item(int b, int hh, int qs, const bf16_t* QKV, const bf16_t* VT, const bf16_t* KMH, const bf16_t* KML, bf16_t* AO, int lane) {
    const int ql = lane & 31, h = lane >> 5, n = qs >> 3, sub = qs & 7;
    const float C = 0.125f * 1.4426950408889634f;
    const int tq = 32 * qs + ql;
    const bf16_t* qp = QKV + (size_t)(b * SEQ + tq) * LD1 + hh * 64 + 8 * h;
    bf16x8 qf[4];
#pragma unroll
    for (int jj = 0; jj < 4; ++jj) qf[jj] = *(const bf16x8*)(qp + 16 * jj);
    unsigned sel = 0u;
    if (n > 0) {
        const int blk = (ql & 3) + 4 * (ql >> 3);
        const bool rowok = ((ql & 4) == 0);
        const float* kp0 = (const float*)KMH + ((size_t)((b * 16 + blk) * 2) * 2048) + hh * 64 + 8 * h;
        f32x16 G;
#pragma unroll
        for (int i = 0; i < 16; ++i) G[i] = 0.f;
#pragma unroll
        for (int jj = 0; jj < 4; ++jj) {
            bf16x8 kh = (bf16x8){0, 0, 0, 0, 0, 0, 0, 0}, kl = kh;
            if (rowok) {
                const f32x4 a0 = *(const f32x4*)(kp0 + 16 * jj), a1 = *(const f32x4*)(kp0 + 16 * jj + 4);
                const f32x4 c0 = *(const f32x4*)(kp0 + 2048 + 16 * jj), c1 = *(const f32x4*)(kp0 + 2048 + 16 * jj + 4);
                const f32x4 m0 = (a0 + c0) * (1.0f / 256.0f), m1 = (a1 + c1) * (1.0f / 256.0f);
                u32x4 hi, lo;
                hi.x = cvtpk(m0[0], m0[1]); hi.y = cvtpk(m0[2], m0[3]); hi.z = cvtpk(m1[0], m1[1]); hi.w = cvtpk(m1[2], m1[3]);
                lo.x = cvtpk(m0[0] - bflo(hi.x), m0[1] - bfhi(hi.x)); lo.y = cvtpk(m0[2] - bflo(hi.y), m0[3] - bfhi(hi.y));
                lo.z = cvtpk(m1[0] - bflo(hi.z), m1[1] - bfhi(hi.z)); lo.w = cvtpk(m1[2] - bflo(hi.w), m1[3] - bfhi(hi.w));
                kh = __builtin_bit_cast(bf16x8, hi); kl = __builtin_bit_cast(bf16x8, lo);
            }
            G = MFMA32(kh, qf[jj], G); G = MFMA32(kl, qf[jj], G);
        }
#pragma unroll
        for (int pick = 0; pick < 3; ++pick) {
            float best = -INFINITY; int bi = -1;
#pragma unroll
            for (int i = 0; i < 16; ++i) { const bool ok = (i < n) && !((sel >> i) & 1u) && (G[i] > best); best = ok ? G[i] : best; bi = ok ? i : bi; }
            if (bi >= 0) sel |= 1u << bi;
        }
        sel = (unsigned)__shfl((int)sel, ql);
    }
    unsigned uni = sel;
#pragma unroll
    for (int o = 1; o < 32; o <<= 1) uni |= (unsigned)__shfl_xor((int)uni, o);
    uni = (unsigned)__builtin_amdgcn_readfirstlane((int)uni);
    float m_run = -1e30f, l_run = 0.f; f32x16 o0, o1;
#pragma unroll
    for (int i = 0; i < 16; ++i) { o0[i] = 0.f; o1[i] = 0.f; }
    const bf16_t* kbase = QKV + (size_t)(b * SEQ + pi32(ql)) * LD1 + 2048 + hh * 64 + 8 * h;
    const bf16_t* vbase = VT + ((size_t)((b * 32 + hh) * 64 + ql) << 12) + 8 * h;
#pragma unroll 1
    for (int blk = 0; blk <= n; ++blk) {
        const bool own = (blk == n);
        if (!own && !((uni >> blk) & 1u)) continue;
        const bool mine = own || ((sel >> blk) & 1u);
        const int ntile = own ? sub + 1 : 8;
#pragma unroll 1
        for (int kt8 = 0; kt8 < ntile; ++kt8) {
            const int key0 = 256 * blk + 32 * kt8;
            const bf16_t* kp = kbase + (size_t)key0 * LD1;
            bf16x8 kf[4];
#pragma unroll
            for (int jj = 0; jj < 4; ++jj) kf[jj] = *(const bf16x8*)(kp + 16 * jj);
            const bf16_t* vp = vbase + key0;
            const bf16x8 v00 = *(const bf16x8*)(vp), v01 = *(const bf16x8*)(vp + 16);
            const bf16x8 v10 = *(const bf16x8*)(vp + ((size_t)32 << 12)), v11 = *(const bf16x8*)(vp + ((size_t)32 << 12) + 16);
            f32x16 s;
#pragma unroll
            for (int i = 0; i < 16; ++i) s[i] = 0.f;
#pragma unroll
            for (int jj = 0; jj < 4; ++jj) s = MFMA32(kf[jj], qf[jj], s);
            const bool diag = own && (kt8 == sub);
#pragma unroll
            for (int i = 0; i < 16; ++i) { const bool ok = mine && (!diag || kofs(i, h) <= ql); s[i] = ok ? s[i] * C : -INFINITY; }
            softmax_pv(s, m_run, l_run, o0, o1, v00, v01, v10, v11);
        }
    }
    const float l = l_run + __shfl_xor(l_run, 32);
    store_o64(AO + (size_t)(b * SEQ + tq) * DM + hh * 64, o0, o1, 1.0f / l, h);
}

#define LBAR() do { asm volatile("s_waitcnt lgkmcnt(0)" ::: "memory"); __builtin_amdgcn_s_barrier(); asm volatile("" ::: "memory"); } while (0)
DI void moba_unit(int b, int hh, int n, const bf16_t* QKV, const bf16_t* VT, const bf16_t* KMH, const bf16_t* KML, bf16_t* AO,
                  LAS unsigned char* lds, int tid, int wave, int lane) {
    const int ql = lane & 31, h = lane >> 5;
    const float C = 0.125f * 1.4426950408889634f;
    const int qin = 32 * wave + ql, tq = 256 * n + qin;
    const int lrow = tid >> 3, lch = tid & 7;
    const bf16_t* kgb = QKV + (size_t)(b * SEQ) * LD1 + 2048 + hh * 64;
    const bf16_t* vgb = VT + ((size_t)((b * 32 + hh) * 64) << 12);
    const unsigned kgo = (unsigned)(lrow * LD1 + 8 * lch), vgo = (unsigned)((lrow << 12) + 8 * lch);
    LAS unsigned char* kw = lds + lrow * 144 + lch * 16;
    LAS unsigned char* vw = kw + 36864;
    const LAS unsigned char* kr = lds + pi32(ql) * 144 + 16 * h;
    const LAS unsigned char* vr = lds + 36864 + ql * 144 + 16 * h;
#define LD_TILE(T, RK, RV) do { const int key0_ = 64 * (T); RK = *(const bf16x8*)(kgb + (size_t)key0_ * LD1 + kgo); RV = *(const bf16x8*)(vgb + key0_ + vgo); } while (0)
#define ST_TILE(buf, RK, RV) do { *(LAS bf16x8*)(kw + (buf) * 9216) = RK; *(LAS bf16x8*)(vw + (buf) * 9216) = RV; } while (0)
    const int ntiles = 4 * (n + 1);
    bf16x8 rkA, rvA, rkB, rvB;
    LD_TILE(0, rkA, rvA); LD_TILE(1, rkB, rvB);
    const bf16_t* qp = QKV + (size_t)(b * SEQ + tq) * LD1 + hh * 64 + 8 * h;
    bf16x8 qf[4];
#pragma unroll
    for (int jj = 0; jj < 4; ++jj) qf[jj] = *(const bf16x8*)(qp + 16 * jj);
    unsigned sel = 0u;
    if (n > 0) {
        const int blk = (ql & 3) + 4 * (ql >> 3);
        const bool rowok = ((ql & 4) == 0);
        const float* kp0 = (const float*)KMH + ((size_t)((b * 16 + blk) * 2) * 2048) + hh * 64 + 8 * h;
        f32x16 Gt;
#pragma unroll
        for (int i = 0; i < 16; ++i) Gt[i] = 0.f;
#pragma unroll
        for (int jj = 0; jj < 4; ++jj) {
            bf16x8 kh = (bf16x8){0, 0, 0, 0, 0, 0, 0, 0}, kl = kh;
            if (rowok) {
                const f32x4 a0 = *(const f32x4*)(kp0 + 16 * jj), a1 = *(const f32x4*)(kp0 + 16 * jj + 4);
                const f32x4 c0 = *(const f32x4*)(kp0 + 2048 + 16 * jj), c1 = *(const f32x4*)(kp0 + 2048 + 16 * jj + 4);
                const f32x4 m0 = (a0 + c0) * (1.0f / 256.0f), m1 = (a1 + c1) * (1.0f / 256.0f);
                u32x4 hi, lo;
                hi.x = cvtpk(m0[0], m0[1]); hi.y = cvtpk(m0[2], m0[3]); hi.z = cvtpk(m1[0], m1[1]); hi.w = cvtpk(m1[2], m1[3]);
                lo.x = cvtpk(m0[0] - bflo(hi.x), m0[1] - bfhi(hi.x)); lo.y = cvtpk(m0[2] - bflo(hi.y), m0[3] - bfhi(hi.y));
                lo.z = cvtpk(m1[0] - bflo(hi.z), m1[1] - bfhi(hi.z)); lo.w = cvtpk(m1[2] - bflo(hi.w), m1[3] - bfhi(hi.w));
                kh = __builtin_bit_cast(bf16x8, hi); kl = __builtin_bit_cast(bf16x8, lo);
            }
            Gt = MFMA32(kh, qf[jj], Gt); Gt = MFMA32(kl, qf[jj], Gt);
        }
#pragma unroll
        for (int pick = 0; pick < 3; ++pick) {
            float best = -INFINITY; int bi = -1;
#pragma unroll
            for (int i = 0; i < 16; ++i) { const bool ok = (i < n) && !((sel >> i) & 1u) && (Gt[i] > best); best = ok ? Gt[i] : best; bi = ok ? i : bi; }
            if (bi >= 0) sel |= 1u << bi;
        }
        sel = (unsigned)__shfl((int)sel, ql);
    }
    unsigned uni = sel;
#pragma unroll
    for (int o = 1; o < 32; o <<= 1) uni |= (unsigned)__shfl_xor((int)uni, o);
    uni = (unsigned)__builtin_amdgcn_readfirstlane((int)uni);
    float m_run = -1e30f, l_run = 0.f; f32x16 o0, o1;
#pragma unroll
    for (int i = 0; i < 16; ++i) { o0[i] = 0.f; o1[i] = 0.f; }
#define MOBA_KLD(koff, KF) do { const LAS unsigned char* kb_ = kr + (koff); \
        _Pragma("unroll") for (int jj = 0; jj < 4; ++jj) { KF[2 * jj] = *(const LAS bf16x8*)(kb_ + jj * 32); KF[2 * jj + 1] = *(const LAS bf16x8*)(kb_ + 32 * 144 + jj * 32); } } while (0)
#define MOBA_VLD(voff, VF) do { const LAS unsigned char* vb_ = vr + (voff); \
        VF[0] = *(const LAS bf16x8*)(vb_); VF[1] = *(const LAS bf16x8*)(vb_ + 32); VF[2] = *(const LAS bf16x8*)(vb_ + 64); VF[3] = *(const LAS bf16x8*)(vb_ + 96); \
        VF[4] = *(const LAS bf16x8*)(vb_ + 32 * 144); VF[5] = *(const LAS bf16x8*)(vb_ + 32 * 144 + 32); VF[6] = *(const LAS bf16x8*)(vb_ + 32 * 144 + 64); VF[7] = *(const LAS bf16x8*)(vb_ + 32 * 144 + 96); } while (0)
#define MOBA_QK(KF, S0, S1) do { \
        _Pragma("unroll") for (int i = 0; i < 16; ++i) { S0[i] = 0.f; S1[i] = 0.f; } \
        _Pragma("unroll") for (int jj = 0; jj < 4; ++jj) { S0 = MFMA32(KF[2 * jj], qf[jj], S0); S1 = MFMA32(KF[2 * jj + 1], qf[jj], S1); } } while (0)
#define MOBA_SMPV(T, VF, s0_, s1_) do { \
        const int blk_ = (T) >> 2, kt_ = (T) & 3; const bool own_ = (blk_ == n); \
        const bool act_ = own_ ? (64 * kt_ <= 32 * wave + 31) : (((uni >> blk_) & 1u) != 0u); \
        if (act_) { \
            const bool mine_ = own_ || (((sel >> blk_) & 1u) != 0u); \
            float mnew_; \
            if (own_ && (64 * kt_ + 63 > 32 * wave)) {              \
                const int lim_ = qin - 64 * kt_ - 8 * h; \
                _Pragma("unroll") for (int i = 0; i < 16; ++i) { \
                    const int kc_ = 16 * (i >> 3) + (i & 7); \
                    s0_[i] = (kc_ <= lim_) ? s0_[i] * C : -INFINITY; s1_[i] = (kc_ + 32 <= lim_) ? s1_[i] * C : -INFINITY; } \
                float mx_ = fmaxf(s0_[0], s1_[0]); \
                _Pragma("unroll") for (int i = 1; i < 16; ++i) mx_ = fmaxf(fmaxf(mx_, s0_[i]), s1_[i]); \
                mx_ = xhalf_max(mx_); \
                mnew_ = fmaxf(m_run, mx_); \
                _Pragma("unroll") for (int i = 0; i < 16; ++i) { s0_[i] = fexp2(s0_[i] - mnew_); s1_[i] = fexp2(s1_[i] - mnew_); } \
            } else {                                                \
                float mx_ = fmaxf(s0_[0], s1_[0]); \
                _Pragma("unroll") for (int i = 1; i < 16; ++i) mx_ = fmaxf(fmaxf(mx_, s0_[i]), s1_[i]); \
                mx_ = mine_ ? mx_ * C : -INFINITY; \
                mx_ = xhalf_max(mx_); \
                mnew_ = fmaxf(m_run, mx_); \
                const float nb_ = mine_ ? -mnew_ : -INFINITY; \
                s0_ = s0_ * C + nb_; s1_ = s1_ * C + nb_; \
                _Pragma("unroll") for (int i = 0; i < 16; ++i) { s0_[i] = fexp2(s0_[i]); s1_[i] = fexp2(s1_[i]); } \
            } \
            const float alpha_ = fexp2(m_run - mnew_); m_run = mnew_; \
            const f32x16 ps_ = s0_ + s1_; \
            const float sum_ = ((ps_[0] + ps_[1]) + (ps_[2] + ps_[3])) + ((ps_[4] + ps_[5]) + (ps_[6] + ps_[7])) + ((ps_[8] + ps_[9]) + (ps_[10] + ps_[11])) + ((ps_[12] + ps_[13]) + (ps_[14] + ps_[15])); \
            l_run = l_run * alpha_ + sum_; \
            if (__any(alpha_ != 1.0f)) { o0 = o0 * alpha_; o1 = o1 * alpha_; } \
            const bf16x8 p00_ = pack8(s0_, 0), p01_ = pack8(s0_, 1), p10_ = pack8(s1_, 0), p11_ = pack8(s1_, 1); \
            o0 = MFMA32(VF[0], p00_, o0); o0 = MFMA32(VF[1], p01_, o0); o0 = MFMA32(VF[2], p10_, o0); o0 = MFMA32(VF[3], p11_, o0); \
            o1 = MFMA32(VF[4], p00_, o1); o1 = MFMA32(VF[5], p01_, o1); o1 = MFMA32(VF[6], p10_, o1); o1 = MFMA32(VF[7], p11_, o1); \
        } } while (0)
    asm volatile("" :: "v"(qf[0]), "v"(qf[1]), "v"(qf[2]), "v"(qf[3]));
    const int lastT = ntiles - 1;
#define MOBA_PAIR(T, offA, offB) do { \
        const int blk_ = (T) >> 2; \
        if (((uni >> blk_) & 1u) != 0u) { \
            const bool mine_ = (((sel >> blk_) & 1u) != 0u); \
            const LAS unsigned char* ka_ = kr + (offA); const LAS unsigned char* kb_ = kr + (offB); \
            f32x16 a0_, a1_, b0_, b1_; \
            _Pragma("unroll") for (int i = 0; i < 16; ++i) { a0_[i] = 0.f; a1_[i] = 0.f; b0_[i] = 0.f; b1_[i] = 0.f; } \
            _Pragma("unroll") for (int jj = 0; jj < 4; ++jj) { \
                a0_ = MFMA32(*(const LAS bf16x8*)(ka_ + jj * 32), qf[jj], a0_); b0_ = MFMA32(*(const LAS bf16x8*)(kb_ + jj * 32), qf[jj], b0_); \
                a1_ = MFMA32(*(const LAS bf16x8*)(ka_ + 32 * 144 + jj * 32), qf[jj], a1_); b1_ = MFMA32(*(const LAS bf16x8*)(kb_ + 32 * 144 + jj * 32), qf[jj], b1_); } \
            float mxa_ = fmaxf(a0_[0], a1_[0]), mxb_ = fmaxf(b0_[0], b1_[0]); \
            _Pragma("unroll") for (int i = 1; i < 16; ++i) { mxa_ = fmaxf(fmaxf(mxa_, a0_[i]), a1_[i]); mxb_ = fmaxf(fmaxf(mxb_, b0_[i]), b1_[i]); } \
            float mx_ = fmaxf(mxa_, mxb_); \
            mx_ = mine_ ? mx_ * C : -INFINITY; \
            mx_ = xhalf_max(mx_); \
            const float mnew_ = fmaxf(m_run, mx_); \
            const float nb_ = mine_ ? -mnew_ : -INFINITY; \
            a0_ = a0_ * C + nb_; b0_ = b0_ * C + nb_; a1_ = a1_ * C + nb_; b1_ = b1_ * C + nb_; \
            _Pragma("unroll") for (int i = 0; i < 16; ++i) { a0_[i] = fexp2(a0_[i]); b0_[i] = fexp2(b0_[i]); a1_[i] = fexp2(a1_[i]); b1_[i] = fexp2(b1_[i]); } \
            const float alpha_ = fexp2(m_run - mnew_); m_run = mnew_; \
            const f32x16 ps_ = (a0_ + a1_) + (b0_ + b1_); \
            const float sum_ = ((ps_[0] + ps_[1]) + (ps_[2] + ps_[3])) + ((ps_[4] + ps_[5]) + (ps_[6] + ps_[7])) + ((ps_[8] + ps_[9]) + (ps_[10] + ps_[11])) + ((ps_[12] + ps_[13]) + (ps_[14] + ps_[15])); \
            l_run = l_run * alpha_ + sum_; \
            if (__any(alpha_ != 1.0f)) { o0 = o0 * alpha_; o1 = o1 * alpha_; } \
            const LAS unsigned char* va_ = vr + (offA); const LAS unsigned char* vb_ = vr + (offB); \
            { const bf16x8 p_ = pack8(a0_, 0); o0 = MFMA32(*(const LAS bf16x8*)(va_), p_, o0); o1 = MFMA32(*(const LAS bf16x8*)(va_ + 32 * 144), p_, o1); } \
            { const bf16x8 p_ = pack8(a0_, 1); o0 = MFMA32(*(const LAS bf16x8*)(va_ + 32), p_, o0); o1 = MFMA32(*(const LAS bf16x8*)(va_ + 32 * 144 + 32), p_, o1); } \
            { const bf16x8 p_ = pack8(a1_, 0); o0 = MFMA32(*(const LAS bf16x8*)(va_ + 64), p_, o0); o1 = MFMA32(*(const LAS bf16x8*)(va_ + 32 * 144 + 64), p_, o1); } \
            { const bf16x8 p_ = pack8(a1_, 1); o0 = MFMA32(*(const LAS bf16x8*)(va_ + 96), p_, o0); o1 = MFMA32(*(const LAS bf16x8*)(va_ + 32 * 144 + 96), p_, o1); } \
            { const bf16x8 p_ = pack8(b0_, 0); o0 = MFMA32(*(const LAS bf16x8*)(vb_), p_, o0); o1 = MFMA32(*(const LAS bf16x8*)(vb_ + 32 * 144), p_, o1); } \
            { const bf16x8 p_ = pack8(b0_, 1); o0 = MFMA32(*(const LAS bf16x8*)(vb_ + 32), p_, o0); o1 = MFMA32(*(const LAS bf16x8*)(vb_ + 32 * 144 + 32), p_, o1); } \
            { const bf16x8 p_ = pack8(b1_, 0); o0 = MFMA32(*(const LAS bf16x8*)(vb_ + 64), p_, o0); o1 = MFMA32(*(const LAS bf16x8*)(vb_ + 32 * 144 + 64), p_, o1); } \
            { const bf16x8 p_ = pack8(b1_, 1); o0 = MFMA32(*(const LAS bf16x8*)(vb_ + 96), p_, o0); o1 = MFMA32(*(const LAS bf16x8*)(vb_ + 32 * 144 + 96), p_, o1); } \
        } } while (0)
#define MOBA_ONE(T, off) do { f32x16 s0_, s1_; bf16x8 kf_[8]; MOBA_KLD(off, kf_); MOBA_QK(kf_, s0_, s1_); \
        { bf16x8 vf_[8]; MOBA_VLD(off, vf_); MOBA_SMPV(T, vf_, s0_, s1_); } } while (0)
    ST_TILE(0, rkA, rvA); ST_TILE(1, rkB, rvB);
    LD_TILE(2, rkA, rvA); LD_TILE(3, rkB, rvB);
    LBAR();
    int pc = 0;
#pragma unroll 1
    for (int T = 0; T < ntiles; T += 2) {
        if ((T >> 2) < n) { MOBA_PAIR(T, pc, pc + 9216); }
        else { MOBA_ONE(T, pc); MOBA_ONE(T + 1, pc + 9216); }
        const int pnx = pc ^ 18432;
        *(LAS bf16x8*)(kw + pnx) = rkA; *(LAS bf16x8*)(vw + pnx) = rvA; *(LAS bf16x8*)(kw + pnx + 9216) = rkB; *(LAS bf16x8*)(vw + pnx + 9216) = rvB;
        { const int Ta = (T + 4 < lastT) ? T + 4 : lastT, Tb = (T + 5 < lastT) ? T + 5 : lastT; LD_TILE(Ta, rkA, rvA); LD_TILE(Tb, rkB, rvB); }
        LBAR();
        pc = pnx;
    }
#undef MOBA_PAIR
#undef MOBA_ONE
#define MOBA_ROT() do {} while (0)
#undef MOBA_ROT
#undef MOBA_QK
#undef MOBA_KLD
#undef MOBA_VLD
#undef MOBA_SMPV
#define MOBA_COMPUTE_UNUSED
#undef MOBA_COMPUTE_UNUSED
#undef LD_TILE
#undef ST_TILE
    const float l = l_run + __shfl_xor(l_run, 32);
    store_o64(AO + (size_t)(b * SEQ + tq) * DM + hh * 64, o0, o1, 1.0f / l, h);
}

DI void xattn_item(int item, const bf16_t* QX, const bf16_t* MK, const bf16_t* MVT, bf16_t* AO, int lane) {
    const int qs = item & 127, hx = (item >> 7) & 3, b = item >> 9;
    const int ql = lane & 31, h = lane >> 5;
    const float C = 0.04419417382415922f * 1.4426950408889634f;
    const int tq = 32 * qs + ql;
    const bf16_t* qp = QX + (size_t)(b * SEQ + tq) * DM + hx * 512 + 8 * h;
    const bf16_t* kp = MK + (size_t)(b * 256 + pi32(ql)) * DM + hx * 512 + 8 * h;
    f32x16 S[8];
#pragma unroll
    for (int kt = 0; kt < 8; ++kt)
#pragma unroll
        for (int i = 0; i < 16; ++i) S[kt][i] = 0.f;
#pragma unroll 2
    for (int jj = 0; jj < 32; ++jj) {
        const bf16x8 qf = *(const bf16x8*)(qp + 16 * jj);
#pragma unroll
        for (int kt = 0; kt < 8; ++kt) {
            const bf16x8 kf = *(const bf16x8*)(kp + (size_t)(32 * kt) * DM + 16 * jj);
            S[kt] = MFMA32(kf, qf, S[kt]);
        }
    }
    float mx = S[0][0];
#pragma unroll
    for (int kt = 0; kt < 8; ++kt)
#pragma unroll
        for (int i = 0; i < 16; ++i) mx = fmaxf(mx, S[kt][i]);
    mx = fmaxf(mx, __shfl_xor(mx, 32));
    const float mc = mx * C;
    float sum = 0.f;
    bf16x8 pb[8][2];
#pragma unroll
    for (int kt = 0; kt < 8; ++kt) {
#pragma unroll
        for (int i = 0; i < 16; ++i) { S[kt][i] = fexp2(S[kt][i] * C - mc); sum += S[kt][i]; }
        pb[kt][0] = pack8(S[kt], 0); pb[kt][1] = pack8(S[kt], 1);
    }
    sum += __shfl_xor(sum, 32);
    const float inv = 1.0f / sum;
    const bf16_t* vp = MVT + ((size_t)((b * 4 + hx) * 512 + ql) << 8) + 8 * h;
    bf16_t* orow = AO + (size_t)(b * SEQ + tq) * DM + hx * 512 + 4 * h;
#pragma unroll 1
    for (int dt = 0; dt < 16; ++dt) {
        f32x16 acc;
#pragma unroll
        for (int i = 0; i < 16; ++i) acc[i] = 0.f;
        const bf16_t* vr = vp + ((size_t)(32 * dt) << 8);
#pragma unroll
        for (int kt = 0; kt < 8; ++kt) {
            const bf16x8 v0 = *(const bf16x8*)(vr + 32 * kt), v1 = *(const bf16x8*)(vr + 32 * kt + 16);
            acc = MFMA32(v0, pb[kt][0], acc); acc = MFMA32(v1, pb[kt][1], acc);
        }
#pragma unroll
        for (int g4 = 0; g4 < 4; ++g4) {
            u32x2 w; w.x = cvtpk(acc[4 * g4] * inv, acc[4 * g4 + 1] * inv); w.y = cvtpk(acc[4 * g4 + 2] * inv, acc[4 * g4 + 3] * inv);
            *(u32x2*)(orow + 32 * dt + 8 * g4) = w;
        }
    }
}

DI void xattn_unit(int unit, const bf16_t* QX, const bf16_t* MK, const bf16_t* MVT, bf16_t* AOp, LAS unsigned char* lds, int tid, int wave, int lane) {
    constexpr int BUFB = 36864;
    const int qb = unit & 15, hx = (unit >> 4) & 3, b = unit >> 6;
    const int ql = lane & 31, h = lane >> 5;
    const float C = 0.04419417382415922f * 1.4426950408889634f;
    const int tq = 256 * qb + 32 * wave + ql;
    const bf16_t* kg = MK + (size_t)(b * 256 + (tid >> 1)) * DM + hx * 512 + 32 * (tid & 1);
    const bf16_t* vg = MVT + ((size_t)((b * 4 + hx) * 512 + (tid >> 3)) << 8) + 32 * (tid & 7);
    LAS unsigned char* kw = lds + (tid >> 1) * 144 + (tid & 1) * 64;
    LAS unsigned char* vw = lds + (tid >> 3) * 528 + (tid & 7) * 64;
    const LAS unsigned char* kr = lds + pi32(ql) * 144 + 16 * h;
    const LAS unsigned char* vr = lds + ql * 528 + 16 * h;
    const bf16_t* qp = QX + (size_t)(b * SEQ + tq) * DM + hx * 512 + 8 * h;
    bf16_t* orow = AOp + (size_t)(b * SEQ + tq) * DM + hx * 512 + 4 * h;
#define XLD(T, R) do { if ((T) < 8) { _Pragma("unroll") for (int i_ = 0; i_ < 4; ++i_) R[i_] = *(const bf16x8*)(kg + 64 * (T) + 8 * i_); } \
                       else { _Pragma("unroll") for (int i_ = 0; i_ < 4; ++i_) R[i_] = *(const bf16x8*)(vg + ((size_t)(64 * ((T) - 8)) << 8) + 8 * i_); } } while (0)
#define XST(T, buf, R) do { if ((T) < 8) { _Pragma("unroll") for (int i_ = 0; i_ < 4; ++i_) *(LAS bf16x8*)(kw + (buf) * BUFB + 16 * i_) = R[i_]; } \
                            else { _Pragma("unroll") for (int i_ = 0; i_ < 4; ++i_) *(LAS bf16x8*)(vw + (buf) * BUFB + 16 * i_) = R[i_]; } } while (0)
    bf16x8 RA[4], RB[4], qf[4];
    f32x16 S[8];
    bf16x8 pb[8][2];
    float inv = 0.f;
#pragma unroll
    for (int kt = 0; kt < 8; ++kt)
#pragma unroll
        for (int i = 0; i < 16; ++i) S[kt][i] = 0.f;
    XLD(0, RA); XLD(1, RB);
#pragma unroll
    for (int jj = 0; jj < 4; ++jj) qf[jj] = *(const bf16x8*)(qp + 16 * jj);
    XST(0, 0, RA); XLD(2, RA);
    LBAR();
#define XCOMP(T, buf) do { \
        if ((T) < 8) { \
            _Pragma("unroll") for (int jj = 0; jj < 4; ++jj) \
                _Pragma("unroll") for (int kt = 0; kt < 8; ++kt) { \
                    const bf16x8 kf_ = *(const LAS bf16x8*)(kr + (buf) * BUFB + (32 * kt) * 144 + jj * 32); \
                    S[kt] = MFMA32(kf_, qf[jj], S[kt]); } \
            if ((T) + 1 < 8) { _Pragma("unroll") for (int jj = 0; jj < 4; ++jj) qf[jj] = *(const bf16x8*)(qp + 64 * ((T) + 1) + 16 * jj); } \
            if ((T) == 7) { \
                float mx_ = S[0][0]; \
                _Pragma("unroll") for (int kt = 0; kt < 8; ++kt) _Pragma("unroll") for (int i = 0; i < 16; ++i) mx_ = fmaxf(mx_, S[kt][i]); \
                mx_ = xhalf_max(mx_); \
                const float mc_ = -mx_ * C; float sum_ = 0.f; \
                _Pragma("unroll") for (int kt = 0; kt < 8; ++kt) { \
                    S[kt] = S[kt] * C + mc_; \
                    _Pragma("unroll") for (int i = 0; i < 16; ++i) { S[kt][i] = fexp2(S[kt][i]); sum_ += S[kt][i]; } \
                    pb[kt][0] = pack8(S[kt], 0); pb[kt][1] = pack8(S[kt], 1); } \
                sum_ += __shfl_xor(sum_, 32); inv = 1.0f / sum_; } \
        } else { \
            _Pragma("unroll") for (int dt2 = 0; dt2 < 2; ++dt2) { \
                f32x16 acc_; \
                _Pragma("unroll") for (int i = 0; i < 16; ++i) acc_[i] = 0.f; \
                _Pragma("unroll") for (int kt = 0; kt < 8; ++kt) { \
                    const bf16x8 v0_ = *(const LAS bf16x8*)(vr + (buf) * BUFB + (32 * dt2) * 528 + 64 * kt); \
                    const bf16x8 v1_ = *(const LAS bf16x8*)(vr + (buf) * BUFB + (32 * dt2) * 528 + 64 * kt + 32); \
                    acc_ = MFMA32(v0_, pb[kt][0], acc_); acc_ = MFMA32(v1_, pb[kt][1], acc_); } \
                _Pragma("unroll") for (int g4 = 0; g4 < 4; ++g4) { \
                    u32x2 w_; w_.x = cvtpk(acc_[4 * g4] * inv, acc_[4 * g4 + 1] * inv); w_.y = cvtpk(acc_[4 * g4 + 2] * inv, acc_[4 * g4 + 3] * inv); \
                    *(u32x2*)(orow + 64 * ((T) - 8) + 32 * dt2 + 8 * g4) = w_; } } \
        } } while (0)
#define XSTEP2(T) do { \
        XCOMP((T), 0); XST((T) + 1, 1, RB); if ((T) + 3 < 16) XLD((T) + 3, RB); LBAR(); \
        XCOMP((T) + 1, 1); if ((T) + 2 < 16) { XST((T) + 2, 0, RA); if ((T) + 4 < 16) XLD((T) + 4, RA); } LBAR(); } while (0)
    XSTEP2(0); XSTEP2(2); XSTEP2(4); XSTEP2(6); XSTEP2(8); XSTEP2(10); XSTEP2(12); XSTEP2(14);
#undef XSTEP2
#undef XCOMP
#undef XLD
#undef XST
}

DI void ln_rows(const float* y, float* xo, bf16_t* xb, f32x2* stats, const float* gam, const float* bet, int gw, int ngw, int lane) {
    if (gw == 0) {
        f32x4* lg = (f32x4*)((char*)stats + (WS_LNG - WS_STATS)); f32x4* lb = (f32x4*)((char*)stats + (WS_LNB - WS_STATS));
#pragma unroll
        for (int j = 0; j < 8; ++j) { lg[lane + 64 * j] = ((const f32x4*)gam)[lane + 64 * j]; lb[lane + 64 * j] = ((const f32x4*)bet)[lane + 64 * j]; }
    }
    f32x4 gq[8], bq[8];
#pragma unroll
    for (int j = 0; j < 8; ++j) { gq[j] = ((const f32x4*)gam)[lane + 64 * j]; bq[j] = ((const f32x4*)bet)[lane + 64 * j]; }
    for (int row = gw; row < TOK; row += 2 * ngw) {
        const int row2 = row + ngw;
        const bool has2 = row2 < TOK;
        const f32x4* yr = (const f32x4*)(y + (size_t)row * DM) + lane;
        const f32x4* yr2 = (const f32x4*)(y + (size_t)(has2 ? row2 : row) * DM) + lane;
        f32x4 v[8], w[8]; float s = 0.f, t = 0.f;
#pragma unroll
        for (int j = 0; j < 8; ++j) { v[j] = yr[64 * j]; w[j] = yr2[64 * j]; }
#pragma unroll
        for (int j = 0; j < 8; ++j) { s += (v[j][0] + v[j][1]) + (v[j][2] + v[j][3]); t += (w[j][0] + w[j][1]) + (w[j][2] + w[j][3]); }
        const float mean = wave_sum(s) * (1.0f / DM), mean2 = wave_sum(t) * (1.0f / DM);
        float s2 = 0.f, t2 = 0.f;
#pragma unroll
        for (int j = 0; j < 8; ++j) { v[j] = v[j] - mean; s2 += (v[j][0] * v[j][0] + v[j][1] * v[j][1]) + (v[j][2] * v[j][2] + v[j][3] * v[j][3]);
                                      w[j] = w[j] - mean2; t2 += (w[j][0] * w[j][0] + w[j][1] * w[j][1]) + (w[j][2] * w[j][2] + w[j][3] * w[j][3]); }
        const float rstd = 1.0f / sqrtf(wave_sum(s2) * (1.0f / DM) + LN_EPS), rstd2 = 1.0f / sqrtf(wave_sum(t2) * (1.0f / DM) + LN_EPS);
        if (xb && lane == 0) { stats[row] = (f32x2){mean, rstd}; if (has2) stats[row2] = (f32x2){mean2, rstd2}; }
        u32x2* br = (u32x2*)(xb + (size_t)row * DM) + lane;
        u32x2* br2 = (u32x2*)(xb + (size_t)row2 * DM) + lane;
#pragma unroll
        for (int j = 0; j < 8; ++j) {
            const f32x4 g = gq[j], bb = bq[j];
            const f32x4 o = v[j] * rstd * g + bb, o2 = w[j] * rstd2 * g + bb;
            if (xo) { ((f32x4*)(xo + (size_t)row * DM) + lane)[64 * j] = o; if (has2) ((f32x4*)(xo + (size_t)row2 * DM) + lane)[64 * j] = o2; }
            if (xb) { u32x2 p; p.x = cvtpk(o[0], o[1]); p.y = cvtpk(o[2], o[3]); br[64 * j] = p;
            if (has2) { u32x2 q; q.x = cvtpk(o2[0], o2[1]); q.y = cvtpk(o2[2], o2[3]); br2[64 * j] = q; } }
        }
    }
}

DI void transpose_item(const float* W, int K, int N, bf16_t* WT, int mode, LAS float* scr, int item, int lane) {
    const int nblk = N / 32, kb = item / nblk, nb = item - kb * nblk, k0 = 64 * kb, n0 = 32 * nb;
    int drow0 = n0;
    const float wsc = (mode == 1) ? (n0 < DFF ? 1.4426950408889634f : 0.6931471805599453f) : 1.0f;
    if (mode == 1) { if (n0 < DFF) drow0 = (n0 >> 7) * 256 + (n0 & 127); else { const int n1 = n0 - DFF; drow0 = (n1 >> 7) * 256 + 128 + (n1 & 127); } }
    const float* src = W + (size_t)(k0 + (lane >> 5)) * N + n0 + (lane & 31);
#pragma unroll 16
    for (int i = 0; i < 32; ++i) scr[(2 * i + (lane >> 5)) * 33 + (lane & 31)] = src[(size_t)(2 * i) * N];
    asm volatile("s_waitcnt lgkmcnt(0)" ::: "memory");
    const int c = lane & 7;
#pragma unroll
    for (int j = 0; j < 4; ++j) {
        const int n = (lane >> 3) + 8 * j; const LAS float* s = scr + (8 * c) * 33 + n;
        u32x4 o; o.x = cvtpk(s[0 * 33] * wsc, s[1 * 33] * wsc); o.y = cvtpk(s[2 * 33] * wsc, s[3 * 33] * wsc); o.z = cvtpk(s[4 * 33] * wsc, s[5 * 33] * wsc); o.w = cvtpk(s[6 * 33] * wsc, s[7 * 33] * wsc);
        *(u32x4*)(WT + (size_t)(drow0 + n) * K + k0 + 8 * c) = o;
    }
    asm volatile("s_waitcnt lgkmcnt(0)" ::: "memory");
}
DI void cvt_rows(const float* src, bf16_t* dst, size_t n8, int gt, int ngt) {
    size_t i = gt;
    for (; i + 3 * (size_t)ngt < n8; i += 4 * (size_t)ngt) {
        f32x4 a[4], b[4];
#pragma unroll
        for (int u = 0; u < 4; ++u) { a[u] = ((const f32x4*)src)[2 * (i + u * (size_t)ngt)]; b[u] = ((const f32x4*)src)[2 * (i + u * (size_t)ngt) + 1]; }
#pragma unroll
        for (int u = 0; u < 4; ++u) { u32x4 w; w.x = cvtpk(a[u][0], a[u][1]); w.y = cvtpk(a[u][2], a[u][3]); w.z = cvtpk(b[u][0], b[u][1]); w.w = cvtpk(b[u][2], b[u][3]); ((u32x4*)dst)[i + u * (size_t)ngt] = w; }
    }
    for (; i < n8; i += ngt) {
        const f32x4 a = ((const f32x4*)src)[2 * i], b = ((const f32x4*)src)[2 * i + 1];
        u32x4 w; w.x = cvtpk(a[0], a[1]); w.y = cvtpk(a[2], a[3]); w.z = cvtpk(b[0], b[1]); w.w = cvtpk(b[2], b[3]);
        ((u32x4*)dst)[i] = w;
    }
}

#define XB_TMO      128
#define XB_XCNT(j)  (256  + 64 * (j))
#define XB_XSUB(j)  (1280 + 64 * (j))
#define XB_XGEN(j)  (2304 + 64 * (j))
#define XB_TOP      3328
#define XB_TOPGEN   3392
#define XCD_BAR_WORDS 3456
#define XB_SPIN_CAP (1u << 22)
DI unsigned xb_ld(unsigned* p)              { return __hip_atomic_load(p, __ATOMIC_RELAXED, __HIP_MEMORY_SCOPE_AGENT); }
DI unsigned xb_add(unsigned* p, unsigned v) { return __hip_atomic_fetch_add(p, v, __ATOMIC_RELAXED, __HIP_MEMORY_SCOPE_AGENT); }
DI unsigned xb_xcc_id() { return (unsigned)__builtin_amdgcn_s_getreg((3 << 11) | 20) & 0xFu; }
#define XB_SPIN(cond, bar) do { unsigned _sp = 0; while (cond) { __builtin_amdgcn_s_sleep(1); \
    if ((++_sp & 255u) == 0u) { if (xb_ld(&(bar)[XB_TMO])) break; if (_sp > XB_SPIN_CAP) { atomicAdd(&(bar)[XB_TMO], 1u); break; } } } } while (0)
struct XcdBarrier { unsigned* bar; unsigned x; volatile LAS unsigned* st; };
DI XcdBarrier xcd_barrier_post(unsigned* bar, volatile LAS unsigned* st) {
    XcdBarrier b; b.bar = bar; b.x = xb_xcc_id(); b.st = st;
    if (threadIdx.x == 0) (void)xb_add(&bar[XB_XCNT(b.x)], 1u);
    return b;
}
DI void xcd_barrier_complete(unsigned* bar, unsigned x, unsigned& nloc, unsigned& nx) {
    const unsigned G = gridDim.x * gridDim.y * gridDim.z;
    unsigned sum, cnt, mine, sp = 0u;
    for (;;) {
        sum = 0u; cnt = 0u; mine = 0u;
#pragma unroll
        for (unsigned j = 0; j < 16; ++j) { const unsigned c = xb_ld(&bar[XB_XCNT(j)]); sum += c; cnt += (c > 0u) ? 1u : 0u; mine = (j == x) ? c : mine; }
        if (sum == G) break;
        __builtin_amdgcn_s_sleep(1);
        if ((++sp & 255u) == 0u) { if (xb_ld(&bar[XB_TMO])) break; if (sp > XB_SPIN_CAP) { atomicAdd(&bar[XB_TMO], 1u); break; } }
    }
    nloc = mine > 0u ? mine : 1u; nx = cnt > 0u ? cnt : 1u;
}
DI void xcd_barrier(const XcdBarrier& b) {
    asm volatile("s_waitcnt vmcnt(0)" ::: "memory");
    __syncthreads();
    if (threadIdx.x == 0) {
        unsigned* bar = b.bar;
        __builtin_amdgcn_s_waitcnt(0);
        unsigned nloc = b.st[0], nx = b.st[1];
        if (nloc == 0u) { xcd_barrier_complete(bar, b.x, nloc, nx); b.st[0] = nloc; b.st[1] = nx; }
        const unsigned old = xb_add(&bar[XB_XSUB(b.x)], 1u);
        const unsigned gen = old / nloc;
        if (old + 1u == (gen + 1u) * nloc) {
            __builtin_amdgcn_fence(__ATOMIC_RELEASE, "agent");
            asm volatile("s_waitcnt vmcnt(0)" ::: "memory");
            const unsigned og = xb_add(&bar[XB_TOP], 1u);
            const unsigned tg = og / nx;
            if (og + 1u == (tg + 1u) * nx) xb_add(&bar[XB_TOPGEN], 1u);
            else XB_SPIN(xb_ld(&bar[XB_TOPGEN]) == tg, bar);
            __builtin_amdgcn_fence(__ATOMIC_ACQUIRE, "agent");
            xb_add(&bar[XB_XGEN(b.x)], 1u);
            asm volatile("s_waitcnt vmcnt(0)" ::: "memory");
        } else {
            XB_SPIN(xb_ld(&bar[XB_XGEN(b.x)]) == gen, bar);
            __builtin_amdgcn_fence(__ATOMIC_ACQUIRE, "agent");
            asm volatile("s_waitcnt vmcnt(0)" ::: "memory");
        }
    }
    __syncthreads();
}

struct WDesc { const float* src; bf16_t* dst; int K, N, mode, items; };
struct Params { const float* in[40]; float* out; unsigned char* ws; WDesc w[18]; int ph_lo, ph_hi; };

constexpr int LDS_BYTES = 147456;

__global__ void __launch_bounds__(512, 2) mega_fwd(Params P) {
    extern __shared__ __attribute__((aligned(16))) unsigned char lds_raw[];
    LAS unsigned char* lds = (LAS unsigned char*)lds_raw;
    cg::grid_group grid = cg::this_grid();
    volatile LAS unsigned* bst = (volatile LAS unsigned*)(lds + 131072 + 64);
    if (threadIdx.x == 0) { bst[0] = 0u; bst[1] = 0u; }
    __syncthreads();
    const XcdBarrier xbar = xcd_barrier_post((unsigned*)(P.ws + WS_BAR), bst);
    const int tid0 = threadIdx.x;
    const int G = gridDim.x, bx = blockIdx.x;
    const int ngw = G * 8;
    unsigned char* const ws0 = P.ws;
#define XB ((bf16_t*)(ws + WS_XB))
#define AO ((bf16_t*)(ws + WS_AO))
#define VT ((bf16_t*)(ws + WS_VT))
#define BIG ((bf16_t*)(ws + WS_BIG))
#define KMH ((bf16_t*)(ws + WS_KMH))
#define KML ((bf16_t*)(ws + WS_KML))
#define GWB ((bf16_t*)(ws + WS_GW))
#define MEMB ((bf16_t*)(ws + WS_MEMB))
#define STATS ((f32x2*)(ws + WS_STATS))
#define OUT (P.out)
    int ph = 0;
#define PH_LANE int tid = tid0; asm volatile("" : "+v"(tid)); unsigned char* ws = ws0; asm volatile("" : "+s"(ws)); const int lane = tid & 63, wave = __builtin_amdgcn_readfirstlane(tid >> 6), gw = bx * 8 + wave; (void)lane; (void)gw;
#if MK_ONE_LAUNCH
#define PH_BEGIN { PH_LANE
#define PH_END } xcd_barrier(xbar);
#define PH_END_LAST(last) } if (!(last)) xcd_barrier(xbar);
#define PH_END_CG } if (P.ph_lo > 0x40000000) grid.sync(); xcd_barrier(xbar);
#else
#define PH_BEGIN if (ph >= P.ph_lo && ph < P.ph_hi) { PH_LANE
#define PH_END } { if (ph >= P.ph_lo && ph + 1 < P.ph_hi) grid.sync(); ++ph; }
#define PH_END_CG PH_END
#define PH_END_LAST(last) PH_END
#endif

    PH_BEGIN
    {
        LAS float* scr = (LAS float*)(lds + wave * 8704);
        for (int rep = 0; rep < (PROBE == 5 ? 2 : 1); ++rep) {
        int rot = 0;
#pragma unroll 1
        for (int mi = 0; mi < 18; ++mi) {
            const WDesc d = P.w[mi];
            int v = gw - rot; if (v < 0) v += ngw;
            for (int it = v; it < d.items; it += ngw) transpose_item(d.src, d.K, d.N, d.dst, d.mode, scr, it, lane);
            rot = (rot + d.items) % ngw;
        }
        }
        const int gt = bx * 512 + tid, ngt = G * 512;
        cvt_rows(P.in[0], XB, (size_t)TOK * DM / 8, gt, ngt);
        cvt_rows(P.in[1], MEMB, (size_t)1024 * DM / 8, gt, ngt);
        for (int i = gt; i < TOK; i += ngt) STATS[i] = (f32x2){0.f, 1.f};
        for (int i = gt; i < DM; i += ngt) { ((float*)(ws + WS_LNG))[i] = 1.f; ((float*)(ws + WS_LNB))[i] = 0.f; }
        for (int i = gt; i < 8 * 128 * 128; i += ngt) { const int jj = i & 127, ii = (i >> 7) & 127; GWB[i] = (bf16_t)(cvtpk(jj <= ii ? P.in[9][i] : 0.f, 0.f) & 0xffffu); }
    }
    PH_END_CG

#pragma unroll 1
    for (int l = 0; l < 2; ++l) {
        const float* const* IN = P.in + (l == 0 ? 2 : 23);
        const int o_ln2 = (l == 0 ? 10 : 6);
#define WL (ws + WS_W + l * W_LAYER)
        PH_BEGIN
#if PROBE == 6
        { pg8::Gemm g{XB, (const bf16_t*)(WL + WO_FFN1I), TOK, 2 * DFF, DM}; pg8::StaticOrder S; S.init(TOK, 2 * DFF, G, bx);
          pg8::EpiSwiGLU E{0}; pg8::gemm_phase<pg8::EpiSwiGLU>(lds, g, S, E, tid); }
        asm volatile("" : "+v"(tid));
#endif
        { pg8::Gemm g{XB, (const bf16_t*)(WL + WO_FFN1I), TOK, 2 * DFF, DM}; pg8::StaticOrder S; S.init(TOK, 2 * DFF, G, bx);
          pg8::EpiSwiGLU E{0}; pg8::gemm_phase<pg8::EpiSwiGLU>(lds, g, S, E, tid); }
        { const int nfree = G - (43 * 64) % G;
          if (nfree >= 64 && nfree < G) { if (bx >= G - 64) {
              pg8::Gemm g{MEMB, (const bf16_t*)(WL + WO_MEMKV), 1024, 4096, DM}; pg8::StaticOrder S; S.init(1024, 4096, 64, bx - (G - 64));
              pg8::EpiBf16V E{l};
              pg8::gemm_phase<pg8::EpiBf16V>(lds, g, S, E, tid); } }
          else { pg8::Gemm g{MEMB, (const bf16_t*)(WL + WO_MEMKV), 1024, 4096, DM}; pg8::StaticOrder S; S.init(1024, 4096, G, bx);
              pg8::EpiBf16V E{l};
              pg8::gemm_phase<pg8::EpiBf16V>(lds, g, S, E, tid); } }
        PH_END
        PH_BEGIN
        { pg8::Gemm g{BIG, (const bf16_t*)(WL + WO_FFN1O), TOK, DM, DFF}; pg8::StaticOrder S; S.init(TOK, DM, G, bx);
          pg8::EpiResid E{l == 0 ? 3 : 2}; pg8::gemm_phase<pg8::EpiResid>(lds, g, S, E, tid); }
        PH_END
        PH_BEGIN
        ln_rows(OUT, nullptr, XB, STATS, IN[2], IN[3], gw, ngw, lane);
        PH_END
        PH_BEGIN
        if (l == 0) { pg8::Gemm g{XB, (const bf16_t*)(WL + WO_MIXI), TOK, LD0, DM}; pg8::StaticOrder S; S.init(TOK, LD0, G, bx);
          pg8::EpiBf16V E{2}; pg8::gemm_phase<pg8::EpiBf16V>(lds, g, S, E, tid); }
        else {
          { pg8::Gemm g{XB, (const bf16_t*)(WL + WO_MIXI), TOK, 4096, DM}; pg8::StaticOrder S; S.init(TOK, 4096, G, bx);
            pg8::EpiBf16V E{3}; pg8::gemm_phase<pg8::EpiBf16V>(lds, g, S, E, tid); }
          asm volatile("" : "+v"(tid));
          { pg8::Gemm g{(const bf16_t*)(WL + WO_MIXI) + (size_t)4096 * DM, XB, 2048, TOK, DM}; pg8::StaticOrder S; S.init(2048, TOK, G, bx);
            pg8::EpiBf16V E{5}; pg8::gemm_phase<pg8::EpiBf16V>(lds, g, S, E, tid); }
        }
        PH_END
        PH_BEGIN
        if (l == 0) {
#ifndef SKIP_B
            for (int rep = 0; rep < (PROBE == 3 ? 2 : 1); ++rep)
            for (int c = bx; c < 256; c += G) {
                const int ch = c >> 1, g0 = 2 * (c & 1);
                gmlp_unit(ch * 4 + g0, false, BIG, GWB, IN[5], IN[6], IN[8], AO, lds, wave, lane);
                gmlp_unit(ch * 4 + g0 + 1, true, BIG, GWB, IN[5], IN[6], IN[8], AO, lds, wave, lane);
            }
#endif
#ifndef SKIP_A
            for (int rep = 0; rep < (PROBE == 2 ? 2 : 1); ++rep)
            for (int it = gw; it < 4096; it += ngw) mixer_a_item(it, BIG, VT, AO, lane);
#endif
        } else {
            for (int rep = 0; rep < (PROBE == 1 ? 2 : 1); ++rep)
            for (int u = bx; u < 2048; u += G) {
                const int k = u >> 8, v = u & 255, bh = v >> 1, p = v & 1;
                const int n = (k & 1) ? (15 - (k - 1) - p) : (k + p);
                moba_unit(bh >> 5, bh & 31, n, BIG, VT, (const bf16_t*)(ws + WS_KP), KML, AO, lds, tid, wave, lane);
            }
        }
        PH_END
        PH_BEGIN
        { const int Kmix = (l == 0 ? 1536 : 2048);
          pg8::Gemm g{AO, (const bf16_t*)(WL + WO_MIXO), TOK, DM, Kmix}; pg8::StaticOrder S; S.init(TOK, DM, G, bx);
#if PROBE == 7

#endif
          pg8::EpiResid E{0}; pg8::gemm_phase<pg8::EpiResid>(lds, g, S, E, tid); }
        PH_END
        PH_BEGIN
#if PROBE == 8
        ln_rows(OUT, nullptr, BIG, (f32x2*)(BIG + 64 * MiB), IN[o_ln2], IN[o_ln2 + 1], gw, ngw, lane);
#endif
        ln_rows(OUT, nullptr, XB, STATS, IN[o_ln2], IN[o_ln2 + 1], gw, ngw, lane);
        PH_END
        PH_BEGIN
        { pg8::Gemm g{XB, (const bf16_t*)(WL + WO_MEMQ), TOK, DM, DM}; pg8::StaticOrder S; S.init(TOK, DM, G, bx);
          pg8::EpiBf16V E{4}; pg8::gemm_phase<pg8::EpiBf16V>(lds, g, S, E, tid); }
        PH_END
        PH_BEGIN

        for (int u = bx; u < 256; u += G) xattn_unit(u, BIG, (const bf16_t*)(ws + WS_MEMK + l * 4 * MiB), (const bf16_t*)(ws + WS_MEMVT + l * 4 * MiB), AO, lds, tid, wave, lane);
        PH_END
        PH_BEGIN
        { pg8::Gemm g{AO, (const bf16_t*)(WL + WO_MEMO), TOK, DM, DM}; pg8::StaticOrder S; S.init(TOK, DM, G, bx);
          pg8::EpiResid E{0}; pg8::gemm_phase<pg8::EpiResid>(lds, g, S, E, tid); }
        PH_END
        PH_BEGIN
        ln_rows(OUT, nullptr, XB, STATS, IN[o_ln2 + 5], IN[o_ln2 + 6], gw, ngw, lane);
        PH_END
        PH_BEGIN
        { pg8::Gemm g{XB, (const bf16_t*)(WL + WO_FFN2I), TOK, 2 * DFF, DM}; pg8::StaticOrder S; S.init(TOK, 2 * DFF, G, bx);
          pg8::EpiSwiGLU E{0}; pg8::gemm_phase<pg8::EpiSwiGLU>(lds, g, S, E, tid); }
        PH_END
        PH_BEGIN
        { pg8::Gemm g{BIG, (const bf16_t*)(WL + WO_FFN2O), TOK, DM, DFF}; pg8::StaticOrder S; S.init(TOK, DM, G, bx);
          pg8::EpiResid E{2}; pg8::gemm_phase<pg8::EpiResid>(lds, g, S, E, tid); }
        PH_END
        PH_BEGIN
        ln_rows(OUT, l == 1 ? OUT : nullptr, l == 1 ? nullptr : XB, STATS, IN[o_ln2 + 9], IN[o_ln2 + 10], gw, ngw, lane);
        PH_END_LAST(l == 1)
    }
#undef WL
#undef XB
#undef AO
#undef VT
#undef BIG
#undef KMH
#undef KML
#undef GWB
#undef MEMB
#undef STATS
#undef OUT
#undef PH_BEGIN
#undef PH_END
#undef PH_END_CG
#undef PH_END_LAST
}
constexpr int N_PHASES = 1 + 2 * 15;

extern "C" void kernel_launch(void* const* d_in, const int* in_sizes, int n_in, void* d_out, int out_size, void* d_ws, size_t ws_size, hipStream_t stream) {
    static int grid = 0;
    if (grid == 0) {
        if (n_in != 40 || in_sizes[0] != TOK * DM || out_size != TOK * DM || ws_size < WS_END) {
            fprintf(stderr, "kernel_launch: unexpected shapes / workspace (n_in %d, in0 %d, out %d, ws %zu < %zu)\n", n_in, n_in > 0 ? in_sizes[0] : -1, out_size, ws_size, (size_t)WS_END);
            grid = -1; return;
        }
        int dev = 0, cus = 0, per_cu = 0;
        hipGetDevice(&dev);
        hipDeviceGetAttribute(&cus, hipDeviceAttributeMultiprocessorCount, dev);
        if (hipFuncSetAttribute((const void*)mega_fwd, hipFuncAttributeMaxDynamicSharedMemorySize, LDS_BYTES) != hipSuccess) { fprintf(stderr, "kernel_launch: hipFuncSetAttribute failed\n"); grid = -1; return; }
        if (hipOccupancyMaxActiveBlocksPerMultiprocessor(&per_cu, (const void*)mega_fwd, 512, LDS_BYTES) != hipSuccess || per_cu < 1) { fprintf(stderr, "kernel_launch: occupancy query says %d\n", per_cu); per_cu = 1; }
        (void)hipGetLastError();
        grid = cus * (per_cu > 1 ? 1 : per_cu);
        fprintf(stderr, "kernel_launch: grid %d (cus %d, per_cu %d)\n", grid, cus, per_cu);
    }
    if (grid < 0) return;
    Params p{};
    for (int i = 0; i < 40; ++i) p.in[i] = (const float*)d_in[i];
    p.out = (float*)d_out; p.ws = (unsigned char*)d_ws;
    unsigned char* ws = (unsigned char*)d_ws;
    int wi = 0;
    for (int l = 0; l < 2; ++l) {
        const int base = (l == 0 ? 2 : 23);
        const int i_mixi = base + 4, i_mixo = (l == 0 ? base + 9 : base + 5), i_ln2 = (l == 0 ? base + 10 : base + 6);
        unsigned char* WL = ws + WS_W + l * W_LAYER;
        auto add = [&](int idx, size_t off, int K, int N, int mode) { WDesc& d = p.w[wi++]; d.src = (const float*)d_in[idx]; d.dst = (bf16_t*)(WL + off); d.K = K; d.N = N; d.mode = mode; d.items = (K / 64) * (N / 32); };
        add(base + 0, WO_FFN1I, DM, 2 * DFF, 1);
        add(base + 1, WO_FFN1O, DFF, DM, 0);
        add(i_mixi, WO_MIXI, DM, l == 0 ? LD0 : LD1, 0);
        add(i_mixo, WO_MIXO, l == 0 ? 1536 : 2048, DM, 0);
        add(i_ln2 + 2, WO_MEMQ, DM, DM, 0);
        add(i_ln2 + 3, WO_MEMKV, DM, 2 * DM, 0);
        add(i_ln2 + 4, WO_MEMO, DM, DM, 0);
        add(i_ln2 + 7, WO_FFN2I, DM, 2 * DFF, 1);
        add(i_ln2 + 8, WO_FFN2O, DFF, DM, 0);
    }
#if MK_ONE_LAUNCH
    if (hipMemsetAsync(ws + WS_BAR, 0, BAR_BYTES, stream) != hipSuccess) { fprintf(stderr, "kernel_launch: memset failed\n"); return; }
    p.ph_lo = 0; p.ph_hi = N_PHASES;
    void* args[] = {&p};
    hipError_t e = hipLaunchCooperativeKernel((const void*)mega_fwd, dim3(grid), dim3(512), args, LDS_BYTES, stream);
    if (e != hipSuccess) fprintf(stderr, "kernel_launch: cooperative launch failed: %s (grid %d)\n", hipGetErrorString(e), grid);
#else
    for (int ph = 0; ph < N_PHASES; ++ph) {
        p.ph_lo = ph; p.ph_hi = ph + 1;
        hipLaunchKernelGGL(mega_fwd, dim3(grid), dim3(512), LDS_BYTES, stream, p);
    }
#endif
}
```

```cpp
#include <hip/hip_runtime.h>
#include <hip/hip_cooperative_groups.h>
#include <cstdio>
#include <cstdint>
namespace cg = cooperative_groups;

#ifndef PROBE
#define PROBE 0
#endif
#ifndef MK_ONE_LAUNCH
#define MK_ONE_LAUNCH 1
#endif

#define DI __device__ __forceinline__
#define LAS __attribute__((address_space(3)))
typedef unsigned short bf16_t;
typedef short bf16x8 __attribute__((ext_vector_type(8)));
typedef float f32x4 __attribute__((ext_vector_type(4)));
typedef float f32x2 __attribute__((ext_vector_type(2)));
typedef float f32x16 __attribute__((ext_vector_type(16)));
typedef unsigned u32x4 __attribute__((ext_vector_type(4)));
typedef unsigned u32x2 __attribute__((ext_vector_type(2)));
typedef __bf16 bf16x2_t __attribute__((ext_vector_type(2)));

DI unsigned cvtpk(float lo, float hi) { f32x2 v = {lo, hi}; bf16x2_t b = __builtin_convertvector(v, bf16x2_t); return __builtin_bit_cast(unsigned, b); }
DI float bflo(unsigned w) { return __uint_as_float(w << 16); }
DI float bfhi(unsigned w) { return __uint_as_float(w & 0xffff0000u); }
DI float fexp2(float x) { return __builtin_amdgcn_exp2f(x); }
DI float frcp(float x) { return __builtin_amdgcn_rcpf(x); }
DI float wave_sum(float v) {
#pragma unroll
    for (int o = 1; o < 64; o <<= 1) v += __shfl_xor(v, o);
    return v;
}
DI float gelu_t(float x) { const float z = 1.5957691216057308f * (x + 0.044715f * x * x * x); return x * frcp(1.0f + fexp2(-1.4426950408889634f * z)); }
DI float silu_f(float x) { return x * frcp(1.0f + fexp2(-1.4426950408889634f * x)); }

constexpr int TOK = 16384, DM = 2048, DFF = 5504, SEQ = 4096;
constexpr int LD0 = 6656, LD1 = 6144;
constexpr float LN_EPS = 1e-5f;
constexpr float ALPHA = 1.4142135623730951f;

constexpr size_t MiB = 1u << 20;
constexpr size_t WS_KMH = 0, WS_KML = 256 * 1024, WS_GW = 512 * 1024, WS_BAR = 1024 * 1024, BAR_BYTES = 16384, WS_STATS = 768 * 1024, WS_LNG = 896 * 1024, WS_LNB = 904 * 1024;
constexpr size_t WS_MEMB = 2 * MiB, WS_MEMK = 6 * MiB  , WS_MEMVT = 14 * MiB  ;
constexpr size_t WS_W = 22 * MiB, W_LAYER = 195 * MiB;
constexpr size_t WO_FFN1I = 0, WO_FFN1O = 43 * MiB, WO_MIXI = 64 * MiB + MiB / 2, WO_MIXO = 90 * MiB + MiB / 2, WO_MEMQ = 98 * MiB + MiB / 2,
                 WO_MEMKV = 106 * MiB + MiB / 2, WO_MEMO = 122 * MiB + MiB / 2, WO_FFN2I = 130 * MiB + MiB / 2, WO_FFN2O = 173 * MiB + MiB / 2;
constexpr size_t WS_XB = 412 * MiB, WS_AO = 476 * MiB, WS_VT = 540 * MiB, WS_BIG = 604 * MiB, WS_KP = 812 * MiB, WS_END = 813 * MiB;

typedef const char __attribute__((address_space(4)))* kargp_t;
DI kargp_t karg_base() { kargp_t p = (kargp_t)__builtin_amdgcn_kernarg_segment_ptr(); asm volatile("" : "+s"(p)); return p; }
DI const float* karg_in(kargp_t p, int i) { return *(const float* const __attribute__((address_space(4)))*)(p + 8 * i); }
DI float* karg_out(kargp_t p) { return *(float* const __attribute__((address_space(4)))*)(p + 320); }
DI unsigned char* karg_ws(kargp_t p) { return *(unsigned char* const __attribute__((address_space(4)))*)(p + 328); }

namespace pg8 {
constexpr int BM = 256, BK = 64, HALF = 128, HTB = HALF * BK * 2, STAGE_BYTES = 8 * HTB, NXCD = 8, WGM = 4;
DI int lds_byte(int r, int c) { const int st = (r >> 4) * 2 + (c >> 5), rr = r & 15, cc = c & 31, ob = rr * 64 + cc * 2; return st * 1024 + (ob ^ (((ob >> 9) & 1) << 5)); }
DI void stage_rc(int b, int& R, int& C) { const int st = b / 1024, sb = b % 1024, swz = sb ^ (((sb >> 9) & 1) << 5); R = (st >> 1) * 16 + swz / 64; C = (st & 1) * 32 + (swz % 64) / 2; }
DI int perm32(int rho) { const int n = rho >> 4, i = rho & 15; return 8 * (i >> 2) + 4 * n + (i & 3); }

struct Unit { int pm, pn; };
struct Gemm { const bf16_t* A; const bf16_t* Bt; int M, N, K; };

struct StaticOrder {
    int nM, nN, nwg, G, c;
    DI void init(int M, int N, int G_, int c_) { nM = M / BM; nN = N / BM; nwg = nM * nN; G = G_; c = c_; }
    DI bool next(int i, Unit& u) const {
        const long L = (long)i * G + c; if (L >= nwg) return false;
        int wgid = (int)L; { const int q = nwg / NXCD, r = nwg % NXCD, xcd = wgid % NXCD, off = wgid / NXCD; wgid = (xcd < r ? xcd * (q + 1) : r * (q + 1) + (xcd - r) * q) + off; }
        const int nig = WGM * nN, gid = wgid / nig, fm = gid * WGM, gsz = (nM - fm) < WGM ? (nM - fm) : WGM;
        u.pm = fm + ((wgid % nig) % gsz); u.pn = (wgid % nig) / gsz; return true;
    }
};


struct EpiSwiGLU {
    static constexpr bool PERM = true;
    int dummy;
    DI void operator()(const f32x4 (&acc)[2][2][4][2], const Unit& u, int wr, int wc, int fr, int fq) const {
        bf16_t* H = (bf16_t*)(karg_ws(karg_base()) + WS_BIG);
        int row0 = u.pm * BM + wr * 64 + fr, col0 = u.pn * HALF + wc * 32 + 8 * fq;
        asm volatile("" : "+v"(row0), "+v"(col0));
#pragma unroll
        for (int ai = 0; ai < 2; ++ai)
#pragma unroll
            for (int m = 0; m < 4; ++m) {
                bf16_t* rowp = H + (size_t)(row0 + ai * HALF + m * 16) * DFF + col0;
                const f32x4 g0 = acc[ai][0][m][0], g1 = acc[ai][0][m][1], u0 = acc[ai][1][m][0], u1 = acc[ai][1][m][1];
                u32x4 w;
#define SWG(g, u) ((g) * (u) * frcp(1.0f + fexp2(-(g))))
                w.x = cvtpk(SWG(g0[0], u0[0]), SWG(g0[1], u0[1])); w.y = cvtpk(SWG(g0[2], u0[2]), SWG(g0[3], u0[3]));
                w.z = cvtpk(SWG(g1[0], u1[0]), SWG(g1[1], u1[1])); w.w = cvtpk(SWG(g1[2], u1[2]), SWG(g1[3], u1[3]));
#undef SWG
                *(u32x4*)rowp = w;
            }
    }
};
struct EpiResid {
    static constexpr bool PERM = true;
    int flags;
    DI void operator()(const f32x4 (&acc)[2][2][4][2], const Unit& u, int wr, int wc, int fr, int fq) const {
        int row0 = u.pm * BM + wr * 64 + fr, col0 = u.pn * BM + wc * 32 + 8 * fq;
        asm volatile("" : "+v"(row0), "+v"(col0));
        const kargp_t ka = karg_base();
        float* Y = karg_out(ka);
        const float* R = (flags & 1) ? karg_in(ka, 0) : (const float*)Y;
        const unsigned char* wsl = karg_ws(ka);
        const f32x2* stats = (const f32x2*)(wsl + WS_STATS);
        const float scale = (flags & 2) ? 0.5f : 1.0f;
        f32x2 stq[8];
#pragma unroll
        for (int q = 0; q < 8; ++q) stq[q] = stats[row0 + (q >> 2) * HALF + (q & 3) * 16];
#pragma unroll
        for (int bj = 0; bj < 2; ++bj) {
            int cc = col0 + bj * HALF;
            asm volatile("" : "+v"(cc));
            const f32x4 g0 = *(const f32x4*)((const float*)(wsl + WS_LNG) + cc), g1 = *(const f32x4*)((const float*)(wsl + WS_LNG) + cc + 4);
            const f32x4 b0 = *(const f32x4*)((const float*)(wsl + WS_LNB) + cc), b1 = *(const f32x4*)((const float*)(wsl + WS_LNB) + cc + 4);
#pragma unroll
            for (int ai = 0; ai < 2; ++ai)
#pragma unroll
                for (int m = 0; m < 4; ++m) {
                    const int row = row0 + ai * HALF + m * 16;
                    const f32x2 st = stq[ai * 4 + m];
                    const size_t off = (size_t)row * DM + cc;
                    const f32x4 r0 = *(const f32x4*)(R + off), r1 = *(const f32x4*)(R + off + 4);
                    const f32x4 x0 = (r0 - st[0]) * st[1] * g0 + b0, x1 = (r1 - st[0]) * st[1] * g1 + b1;
                    *(f32x4*)(Y + off) = x0 * ALPHA + acc[ai][bj][m][0] * scale;
                    *(f32x4*)(Y + off + 4) = x1 * ALPHA + acc[ai][bj][m][1] * scale;
                }
        }
    }
};
struct EpiBf16V {
    static constexpr bool PERM = true;
    int kind;
    DI void operator()(const f32x4 (&acc)[2][2][4][2], const Unit& u, int wr, int wc, int fr, int fq) const {
        unsigned char* wsl = karg_ws(karg_base());
        bf16_t* O; bf16_t* VT; int ldc, vt_lo, vt_hi, NH, hd_sh, ls, dilated;
        if (kind < 2)       { O = (bf16_t*)(wsl + WS_MEMK + kind * 4 * MiB); VT = (bf16_t*)(wsl + WS_MEMVT + kind * 4 * MiB); ldc = DM; vt_lo = 8; vt_hi = 16; NH = 4; hd_sh = 9; ls = 8; dilated = 0; }
        else if (kind == 2) { O = (bf16_t*)(wsl + WS_BIG); VT = (bf16_t*)(wsl + WS_VT); ldc = LD0; vt_lo = 12; vt_hi = 18; NH = 24; hd_sh = 6; ls = 12; dilated = 1; }
        else if (kind == 3) { O = (bf16_t*)(wsl + WS_BIG); VT = (bf16_t*)(wsl + WS_VT); ldc = LD1; vt_lo = 16; vt_hi = 24; NH = 32; hd_sh = 6; ls = 12; dilated = 0; }
        else if (kind == 4) { O = (bf16_t*)(wsl + WS_BIG); VT = (bf16_t*)(wsl + WS_VT); ldc = DM; vt_lo = 0; vt_hi = 0; NH = 1; hd_sh = 6; ls = 12; dilated = 0; }
        else                { O = (bf16_t*)(wsl + WS_VT) + (size_t)(u.pn >> 4) * ((size_t)2048 * 4096); VT = O; ldc = 4096; vt_lo = 0; vt_hi = 0; NH = 1; hd_sh = 6; ls = 12; dilated = 0; }
        const int pn_eff = (kind == 5) ? (u.pn & 15) : u.pn;
        int row0 = u.pm * BM + wr * 64 + fr; int fq8 = 8 * fq;
        asm volatile("" : "+v"(row0), "+v"(fq8));
        if (u.pn >= vt_lo && u.pn < vt_hi) {
#pragma unroll
            for (int bj = 0; bj < 2; ++bj) {
                const int vc0 = (u.pn - vt_lo) * BM + bj * HALF + wc * 32 + fq8;
                const int head = vc0 >> hd_sh, d0 = vc0 & ((1 << hd_sh) - 1);
                const int sh = dilated ? 2 * (head >> 3) : 0;
                if (sh == 4) {
#pragma unroll
                    for (int ai = 0; ai < 2; ++ai) {
                        const int row = row0 + ai * HALF;
                        const int b = row >> ls, t = row & ((1 << ls) - 1);
                        const int pos = ((t & 15) << (ls - 4)) | (t >> 4);
                        bf16_t* p = VT + ((((size_t)(b * NH + head) << hd_sh) + d0) << ls) + pos;
#pragma unroll
                        for (int e = 0; e < 8; ++e) {
                            u32x2 w; w.x = cvtpk(acc[ai][bj][0][e >> 2][e & 3], acc[ai][bj][1][e >> 2][e & 3]); w.y = cvtpk(acc[ai][bj][2][e >> 2][e & 3], acc[ai][bj][3][e >> 2][e & 3]);
                            *(u32x2*)(p + ((size_t)e << ls)) = w;
                        }
                    }
                } else
#pragma unroll
                for (int ai = 0; ai < 2; ++ai)
#pragma unroll
                    for (int m = 0; m < 4; ++m) {
                        const int row = row0 + ai * HALF + m * 16;
                        const int b = row >> ls, t = row & ((1 << ls) - 1);
                        const int pos = ((t & ((1 << sh) - 1)) << (ls - sh)) | (t >> sh);
                        bf16_t* p = VT + ((((size_t)(b * NH + head) << hd_sh) + d0) << ls) + pos;
#pragma unroll
                        for (int e = 0; e < 8; ++e) p[(size_t)e << ls] = (bf16_t)(cvtpk(acc[ai][bj][m][e >> 2][e & 3], 0.f) & 0xffffu);
                    }
            }
        } else {
            if (kind == 3 && u.pn >= 8) {
                float* kp = (float*)(wsl + WS_KP) + ((size_t)(u.pm * 2 + wr) * 2048) + (u.pn - 8) * BM + wc * 32 + fq8;
#pragma unroll
                for (int bj = 0; bj < 2; ++bj)
#pragma unroll
                    for (int n = 0; n < 2; ++n) {
                        f32x4 cs = (f32x4){0.f, 0.f, 0.f, 0.f};
#pragma unroll
                        for (int ai = 0; ai < 2; ++ai)
#pragma unroll
                            for (int m = 0; m < 4; ++m) cs += acc[ai][bj][m][n];
#pragma unroll
                        for (int e = 0; e < 4; ++e) { float v = cs[e]; v += __shfl_xor(v, 1); v += __shfl_xor(v, 2); v += __shfl_xor(v, 4); v += __shfl_xor(v, 8); cs[e] = v; }
                        if (fr == 0) *(f32x4*)(kp + bj * HALF + 4 * n) = cs;
                    }
            }
            const int col0 = pn_eff * BM + wc * 32 + fq8;
#pragma unroll
            for (int ai = 0; ai < 2; ++ai)
#pragma unroll
                for (int m = 0; m < 4; ++m) {
                    bf16_t* rowp = O + (size_t)(row0 + ai * HALF + m * 16) * ldc + col0;
#pragma unroll
                    for (int bj = 0; bj < 2; ++bj) {
                        const f32x4 v0 = acc[ai][bj][m][0], v1 = acc[ai][bj][m][1];
                        u32x4 w; w.x = cvtpk(v0[0], v0[1]); w.y = cvtpk(v0[2], v0[3]); w.z = cvtpk(v1[0], v1[1]); w.w = cvtpk(v1[2], v1[3]);
                        *(u32x4*)(rowp + bj * HALF) = w;
                    }
                }
        }
    }
};

template <class Epi>
DI void gemm_phase(LAS unsigned char* lds, const Gemm g, const StaticOrder& S, const Epi& E, const int tid) {
    const int wid = __builtin_amdgcn_readfirstlane(tid >> 6), lane = tid & 63, wr = wid >> 2, wc = wid & 3, fr = lane & 15, fq = lane >> 4;
    const int K = g.K, nt = K / BK;
    unsigned voffA[2], voffB[2];
#pragma unroll
    for (int i = 0; i < 2; ++i) { int R, C; stage_rc(tid * 16 + i * 8192, R, C); const int Rb = Epi::PERM ? ((R & ~31) + perm32(R & 31)) : R;
        voffA[i] = (unsigned)(R * K + C) * 2u; voffB[i] = (unsigned)(Rb * K + C) * 2u; }
    const size_t kstep = (size_t)(BK * 2);
    const size_t hstep = (size_t)HALF * K * 2;
    const size_t tstep = 2 * hstep;
    const unsigned ldsw = (unsigned)wid * 1024u;
    const int aoff = lds_byte(wr * 64 + fr, fq * 8), boff = lds_byte(wc * 32 + fr, fq * 8);
#define PG8_SA(b, h) (((b) * 2 + (h)) * HTB)
#define PG8_SB(b, h) ((4 + (b) * 2 + (h)) * HTB)
#define PG8_STAGE(bufoff, gbase, voff) do { _Pragma("unroll") for (int _i = 0; _i < 2; ++_i) \
        __builtin_amdgcn_global_load_lds((const unsigned*)((const char*)(gbase) + (voff)[_i]), (LAS unsigned*)(lds + (bufoff) + ldsw + _i * 8192), 16, 0, 0); } while (0)
#define PG8_LDA(dst, b, h) do { _Pragma("unroll") for (int m = 0; m < 4; ++m) _Pragma("unroll") for (int k = 0; k < 2; ++k) dst[m][k] = *(const LAS bf16x8*)(lds + PG8_SA(b, h) + aoff + m * 2048 + k * 1024); } while (0)
#define PG8_LDB(dst, b, h) do { _Pragma("unroll") for (int n = 0; n < 2; ++n) _Pragma("unroll") for (int k = 0; k < 2; ++k) dst[n][k] = *(const LAS bf16x8*)(lds + PG8_SB(b, h) + boff + n * 2048 + k * 1024); } while (0)
#define PG8_MMA(ai, bj, At, Bt) do { __builtin_amdgcn_s_setprio(1); _Pragma("unroll") for (int m = 0; m < 4; ++m) _Pragma("unroll") for (int n = 0; n < 2; ++n) _Pragma("unroll") for (int k = 0; k < 2; ++k) \
        acc[ai][bj][m][n] = __builtin_amdgcn_mfma_f32_16x16x32_bf16(Bt[n][k], At[m][k], acc[ai][bj][m][n], 0, 0, 0); __builtin_amdgcn_s_setprio(0); } while (0)
#define PG8_WAIT_V(n) asm volatile("s_waitcnt vmcnt(" #n ")" ::: "memory")
#define PG8_WAIT_L(n) asm volatile("s_waitcnt lgkmcnt(" #n ")" ::: "memory")
#define PG8_BAR __builtin_amdgcn_s_barrier()
#define PG8_SCHED __builtin_amdgcn_sched_barrier(0)
    Unit cur, nxt; int ui = 0;
    if (!S.next(0, cur)) return;
    f32x4 acc[2][2][4][2];
#pragma unroll
    for (int a = 0; a < 2; ++a)
#pragma unroll
        for (int b = 0; b < 2; ++b)
#pragma unroll
            for (int m = 0; m < 4; ++m)
#pragma unroll
                for (int n = 0; n < 2; ++n) acc[a][b][m][n] = (f32x4){0.f, 0.f, 0.f, 0.f};
    bf16x8 At[4][2], B0[2][2], B1[2][2];
    const char* cA = (const char*)g.A + (size_t)cur.pm * tstep; const char* cB = (const char*)g.Bt + (size_t)cur.pn * tstep;
    PG8_STAGE(PG8_SB(0, 0), cB, voffB); PG8_STAGE(PG8_SB(0, 1), cB + hstep, voffB); PG8_STAGE(PG8_SA(0, 0), cA, voffA); PG8_STAGE(PG8_SA(0, 1), cA + hstep, voffA);
    if (wr == 1) PG8_BAR;
    PG8_WAIT_V(2); PG8_BAR;
    PG8_STAGE(PG8_SB(1, 0), cB + kstep, voffB); PG8_STAGE(PG8_SA(1, 0), cA + kstep, voffA); PG8_STAGE(PG8_SB(1, 1), cB + hstep + kstep, voffB);
    PG8_WAIT_V(6); PG8_BAR;
    for (;;) {
        const bool has_next = S.next(ui + 1, nxt);
        const char* nA = has_next ? (const char*)g.A + (size_t)nxt.pm * tstep : cA; const char* nB = has_next ? (const char*)g.Bt + (size_t)nxt.pn * tstep : cB;
        for (int t = 0; t < nt; t += 2) {
            const bool last = (t == nt - 2);
            const char* a1 = cA + (size_t)(t + 1) * kstep;
            const char* a2 = last ? nA : cA + (size_t)(t + 2) * kstep; const char* b2 = last ? nB : cB + (size_t)(t + 2) * kstep;
            const char* a3 = a2 + kstep; const char* b3 = b2 + kstep;
            PG8_LDB(B0, 0, 0); PG8_LDB(B1, 0, 1); PG8_SCHED; PG8_LDA(At, 0, 0); PG8_STAGE(PG8_SA(1, 1), a1 + hstep, voffA);
            PG8_WAIT_V(8); PG8_WAIT_L(0); PG8_BAR; PG8_MMA(0, 0, At, B0); PG8_MMA(0, 1, At, B1); PG8_BAR; PG8_SCHED;
            PG8_LDA(At, 0, 1); PG8_STAGE(PG8_SB(0, 0), b2, voffB); PG8_STAGE(PG8_SB(0, 1), b2 + hstep, voffB); PG8_STAGE(PG8_SA(0, 0), a2, voffA);
            PG8_WAIT_V(8); PG8_WAIT_L(0); PG8_BAR; PG8_MMA(1, 0, At, B0); PG8_MMA(1, 1, At, B1); PG8_BAR; PG8_SCHED;
            PG8_LDB(B0, 1, 0); PG8_LDB(B1, 1, 1); PG8_SCHED; PG8_LDA(At, 1, 0); PG8_STAGE(PG8_SA(0, 1), a2 + hstep, voffA);
            PG8_WAIT_V(8); PG8_WAIT_L(0); PG8_BAR; PG8_MMA(0, 0, At, B0); PG8_MMA(0, 1, At, B1); PG8_BAR; PG8_SCHED;
            PG8_LDA(At, 1, 1); PG8_STAGE(PG8_SB(1, 0), b3, voffB); PG8_STAGE(PG8_SB(1, 1), b3 + hstep, voffB); PG8_STAGE(PG8_SA(1, 0), a3, voffA);
            PG8_WAIT_V(8); PG8_WAIT_L(0); PG8_BAR; PG8_MMA(1, 0, At, B0); PG8_MMA(1, 1, At, B1); PG8_BAR; PG8_SCHED;
        }
        if (wr == 0) PG8_BAR;
        E(acc, cur, wr, wc, fr, fq);
        if (!has_next) break;
#pragma unroll
        for (int a = 0; a < 2; ++a)
#pragma unroll
            for (int b = 0; b < 2; ++b)
#pragma unroll
                for (int m = 0; m < 4; ++m)
#pragma unroll
                    for (int n = 0; n < 2; ++n) acc[a][b][m][n] = (f32x4){0.f, 0.f, 0.f, 0.f};
        cur = nxt; cA = nA; cB = nB; ++ui;
        if (wr == 1) PG8_BAR;
    }
    PG8_WAIT_V(0);
    PG8_BAR;
#undef PG8_SA
#undef PG8_SB
#undef PG8_STAGE
#undef PG8_LDA
#undef PG8_LDB
#undef PG8_MMA
#undef PG8_WAIT_V
#undef PG8_WAIT_L
#undef PG8_BAR
#undef PG8_SCHED
}
}

#define MFMA32(a, b, c) __builtin_amdgcn_mfma_f32_32x32x16_bf16((a), (b), (c), 0, 0, 0)
DI int pi32(int rho) { return (rho & ~12) | ((rho & 4) << 1) | ((rho & 8) >> 1); }
DI int kofs(int i, int h) { return 16 * (i >> 3) + 8 * h + (i & 7); }
DI float xhalf_max(float m) { auto rr = __builtin_amdgcn_permlane32_swap(__float_as_uint(m), __float_as_uint(m), false, false); return fmaxf(__uint_as_float(rr[0]), __uint_as_float(rr[1])); }
DI bf16x8 pack8(const f32x16& p, int s) {
    u32x4 w; w.x = cvtpk(p[8 * s], p[8 * s + 1]); w.y = cvtpk(p[8 * s + 2], p[8 * s + 3]); w.z = cvtpk(p[8 * s + 4], p[8 * s + 5]); w.w = cvtpk(p[8 * s + 6], p[8 * s + 7]);
    return __builtin_bit_cast(bf16x8, w);
}
DI void softmax_pv(const f32x16& s, float& m_run, float& l_run, f32x16& o0, f32x16& o1, bf16x8 v00, bf16x8 v01, bf16x8 v10, bf16x8 v11) {
    float mx = s[0];
#pragma unroll
    for (int i = 1; i < 16; ++i) mx = fmaxf(mx, s[i]);
    mx = xhalf_max(mx);
    const float mnew = fmaxf(m_run, mx);
    const float alpha = fexp2(m_run - mnew);
    m_run = mnew;
    f32x16 p; float sum = 0.f;
#pragma unroll
    for (int i = 0; i < 16; ++i) { p[i] = fexp2(s[i] - mnew); sum += p[i]; }
    l_run = l_run * alpha + sum;
    if (__any(alpha != 1.0f)) { o0 = o0 * alpha; o1 = o1 * alpha; }
    const bf16x8 pb0 = pack8(p, 0), pb1 = pack8(p, 1);
    o0 = MFMA32(v00, pb0, o0); o0 = MFMA32(v01, pb1, o0);
    o1 = MFMA32(v10, pb0, o1); o1 = MFMA32(v11, pb1, o1);
}
DI void store_o64(bf16_t* orow, const f32x16& o0, const f32x16& o1, float inv, int h) {
#pragma unroll
    for (int g4 = 0; g4 < 4; ++g4) {
        u32x2 w0, w1;
        w0.x = cvtpk(o0[4 * g4] * inv, o0[4 * g4 + 1] * inv); w0.y = cvtpk(o0[4 * g4 + 2] * inv, o0[4 * g4 + 3] * inv);
        w1.x = cvtpk(o1[4 * g4] * inv, o1[4 * g4 + 1] * inv); w1.y = cvtpk(o1[4 * g4 + 2] * inv, o1[4 * g4 + 3] * inv);
        *(u32x2*)(orow + 8 * g4 + 4 * h) = w0;
        *(u32x2*)(orow + 32 + 8 * g4 + 4 * h) = w1;
    }
}

DI void mixer_a_item(int item, const bf16_t* QKV, const bf16_t* VT, bf16_t* AO, int lane) {
    const int qs = item & 7, r = (item >> 3) & 15, j = (item >> 7) & 7, b = item >> 10;
    const int ql = lane & 31, h = lane >> 5;
    const float C = 0.125f * 1.4426950408889634f;
    const int tq = 16 * (32 * qs + ql) + r;
    float m_run = -1e30f, l_run = 0.f; f32x16 o0, o1;
#pragma unroll
    for (int i = 0; i < 16; ++i) { o0[i] = 0.f; o1[i] = 0.f; }
#pragma unroll 1
    for (int g = 0; g < 3; ++g) {
        const int sh = 2 * g, dil = 1 << sh, Lg = SEQ >> sh, head = 8 * g + j, rg = r & (dil - 1);
        const int mq = tq >> sh, mq_min = (512 * qs + r) >> sh, mq_max = (16 * (32 * qs + 31) + r) >> sh;
        int klo = mq_min - 128; klo = klo < 0 ? 0 : klo; klo &= ~31;
        const bf16_t* qp = QKV + (size_t)(b * SEQ + tq) * LD0 + head * 64 + 8 * h;
        bf16x8 qf[4];
#pragma unroll
        for (int jj = 0; jj < 4; ++jj) qf[jj] = *(const bf16x8*)(qp + 16 * jj);
        const bf16_t* kbase = QKV + (size_t)(b * SEQ + rg) * LD0 + 1536 + head * 64 + 8 * h;
        const bf16_t* vbase = VT + ((size_t)((b * 24 + head) * 64 + ql) << 12) + rg * Lg + 8 * h;
#pragma unroll 1
        for (int kt = klo; kt <= mq_max; kt += 32) {
            const bf16_t* kp = kbase + (size_t)((kt + pi32(ql)) << sh) * LD0;
            bf16x8 kf[4];
#pragma unroll
            for (int jj = 0; jj < 4; ++jj) kf[jj] = *(const bf16x8*)(kp + 16 * jj);
            const bf16_t* vp = vbase + kt;
            const bf16x8 v00 = *(const bf16x8*)(vp), v01 = *(const bf16x8*)(vp + 16);
            const bf16x8 v10 = *(const bf16x8*)(vp + ((size_t)32 << 12)), v11 = *(const bf16x8*)(vp + ((size_t)32 << 12) + 16);
            f32x16 s;
#pragma unroll
            for (int i = 0; i < 16; ++i) s[i] = 0.f;
#pragma unroll
            for (int jj = 0; jj < 4; ++jj) s = MFMA32(kf[jj], qf[jj], s);
#pragma unroll
            for (int i = 0; i < 16; ++i) { const int dist = mq - (kt + kofs(i, h)); s[i] = (dist >= 0 && dist <= 128) ? s[i] * C : -INFINITY; }
            softmax_pv(s, m_run, l_run, o0, o1, v00, v01, v10, v11);
        }
    }
    const float l = l_run + __shfl_xor(l_run, 32);
    store_o64(AO + (size_t)(b * SEQ + tq) * 1536 + j * 64, o0, o1, 1.0f / l, h);
}

DI void gmlp_unit(int unit, bool reuse, const bf16_t* QKV, const bf16_t* Wb, const float* lng, const float* lnb, const float* bs, bf16_t* AO,
                  LAS unsigned char* lds, int wave, int lane) {
    const int gp = unit & 3, n = (unit >> 2) & 31, b = unit >> 7;
    LAS f32x2* STl = (LAS f32x2*)(lds + 69632);
    LAS bf16_t* VTl = (LAS bf16_t*)lds;
    const size_t row0 = (size_t)b * SEQ + 128 * n;
    const f32x4 gam = *(const f32x4*)(lng + 256 * gp + 4 * lane), bet = *(const f32x4*)(lnb + 256 * gp + 4 * lane);
#pragma unroll 4
    for (int tt = 0; tt < 16; ++tt) {
        const int tok = 16 * wave + tt;
        const bf16_t* vr = QKV + (row0 + tok) * LD0 + 5632;
        float mean, rstd;
        if (!reuse) {
            const u32x4 a = *(const u32x4*)(vr + 8 * lane), c = *(const u32x4*)(vr + 512 + 8 * lane);
            float x[16];
#pragma unroll
            for (int e = 0; e < 4; ++e) { x[2 * e] = gelu_t(bflo(a[e])); x[2 * e + 1] = gelu_t(bfhi(a[e])); x[8 + 2 * e] = gelu_t(bflo(c[e])); x[9 + 2 * e] = gelu_t(bfhi(c[e])); }
            float s = 0.f;
#pragma unroll
            for (int e = 0; e < 16; ++e) s += x[e];
            mean = wave_sum(s) * (1.0f / 1024.0f);
            float s2 = 0.f;
#pragma unroll
            for (int e = 0; e < 16; ++e) { const float d = x[e] - mean; s2 += d * d; }
            rstd = 1.0f / sqrtf(wave_sum(s2) * (1.0f / 1024.0f) + LN_EPS);
            if (lane == 0) STl[tok] = (f32x2){mean, rstd};
        } else { const f32x2 st = STl[tok]; mean = st[0]; rstd = st[1]; }
        const u32x2 raw = *(const u32x2*)(vr + 256 * gp + 4 * lane);
        const float y0 = (gelu_t(bflo(raw.x)) - mean) * rstd * gam[0] + bet[0], y1 = (gelu_t(bfhi(raw.x)) - mean) * rstd * gam[1] + bet[1];
        const float y2 = (gelu_t(bflo(raw.y)) - mean) * rstd * gam[2] + bet[2], y3 = (gelu_t(bfhi(raw.y)) - mean) * rstd * gam[3] + bet[3];
        const unsigned w01 = cvtpk(y0, y1), w23 = cvtpk(y2, y3);
        VTl[(4 * lane + 0) * 136 + tok] = (bf16_t)(w01 & 0xffffu); VTl[(4 * lane + 1) * 136 + tok] = (bf16_t)(w01 >> 16);
        VTl[(4 * lane + 2) * 136 + tok] = (bf16_t)(w23 & 0xffffu); VTl[(4 * lane + 3) * 136 + tok] = (bf16_t)(w23 >> 16);
    }
    __syncthreads();
    {
        const int ql = lane & 31, h = lane >> 5, g = 2 * gp + (wave >> 2);
        const LAS bf16_t* arow = VTl + (32 * wave + ql) * 136 + 8 * h;
#pragma unroll 1
        for (int it = 0; it < 4; ++it) {
            const int i = 32 * it + ql;
            const bf16_t* wrow = Wb + ((size_t)g * 128 + i) * 128 + 8 * h;
            f32x16 acc;
#pragma unroll
            for (int e = 0; e < 16; ++e) acc[e] = 0.f;
#pragma unroll 2
            for (int js = 0; js <= 2 * it + 1; ++js) {
                const bf16x8 af = *(const LAS bf16x8*)(arow + 16 * js);
                const bf16x8 bfr = *(const bf16x8*)(wrow + 16 * js);
                acc = MFMA32(af, bfr, acc);
            }
            const float bias = bs[g * 128 + i];
            const bf16_t* urow = QKV + (row0 + i) * LD0 + 4608 + 256 * gp + 32 * wave + 4 * h;
            bf16_t* orow = AO + (row0 + i) * 1536 + 512 + 256 * gp + 32 * wave + 4 * h;
#pragma unroll
            for (int qd = 0; qd < 4; ++qd) {
                const u32x2 uu = *(const u32x2*)(urow + 8 * qd);
                u32x2 w;
                w.x = cvtpk(gelu_t(bflo(uu.x)) * (acc[4 * qd] + bias), gelu_t(bfhi(uu.x)) * (acc[4 * qd + 1] + bias));
                w.y = cvtpk(gelu_t(bflo(uu.y)) * (acc[4 * qd + 2] + bias), gelu_t(bfhi(uu.y)) * (acc[4 * qd + 3] + bias));
                *(u32x2*)(orow + 8 * qd) = w;
            }
        }
    }
    __syncthreads();
}

DI void kmean_item(int item, const bf16_t* QKV, bf16_t* KMH, bf16_t* KML, int lane) {
    const int blk = item & 15, hh = (item >> 4) & 31, b = item >> 9;
    const int dc = lane & 7, rgp = lane >> 3;
    const bf16_t* kp = QKV + (size_t)(b * SEQ + 256 * blk + rgp) * LD1 + 2048 + hh * 64 + 8 * dc;
    float s[8];
#pragma unroll
    for (int e = 0; e < 8; ++e) s[e] = 0.f;
#pragma unroll 8
    for (int i = 0; i < 32; ++i) {
        const u32x4 v = *(const u32x4*)(kp + (size_t)(8 * i) * LD1);
#pragma unroll
        for (int e = 0; e < 4; ++e) { s[2 * e] += bflo(v[e]); s[2 * e + 1] += bfhi(v[e]); }
    }
#pragma unroll
    for (int e = 0; e < 8; ++e) { s[e] += __shfl_xor(s[e], 8); s[e] += __shfl_xor(s[e], 16); s[e] += __shfl_xor(s[e], 32); s[e] *= (1.0f / 256.0f); }
    if (rgp == 0) {
        u32x4 hi, lo;
#pragma unroll
        for (int e = 0; e < 4; ++e) {
            const unsigned hw = cvtpk(s[2 * e], s[2 * e + 1]); hi[e] = hw;
            lo[e] = cvtpk(s[2 * e] - bflo(hw), s[2 * e + 1] - bfhi(hw));
        }
        const size_t o = (size_t)item * 64 + 8 * dc;
        *(u32x4*)(KMH + o) = hi; *(u32x4*)(KML + o) = lo;
    }
}

DI void moba_item(int b, int hh, int qs, const bf16_t* QKV, const bf16_t* VT, const bf16_t* KMH, const bf16_t* KML, bf16_t* AO, int lane) {
    const int ql = lane & 31, h = lane >> 5, n = qs >> 3, sub = qs & 7;
    const float C = 0.125f * 1.4426950408889634f;
    const int tq = 32 * qs + ql;
    const bf16_t* qp = QKV + (size_t)(b * SEQ + tq) * LD1 + hh * 64 + 8 * h;
    bf16x8 qf[4];
#pragma unroll
    for (int jj = 0; jj < 4; ++jj) qf[jj] = *(const bf16x8*)(qp + 16 * jj);
    unsigned sel = 0u;
    if (n > 0) {
        const int blk = (ql & 3) + 4 * (ql >> 3);
        const bool rowok = ((ql & 4) == 0);
        const float* kp0 = (const float*)KMH + ((size_t)((b * 16 + blk) * 2) * 2048) + hh * 64 + 8 * h;
        f32x16 G;
#pragma unroll
        for (int i = 0; i < 16; ++i) G[i] = 0.f;
#pragma unroll
        for (int jj = 0; jj < 4; ++jj) {
            bf16x8 kh = (bf16x8){0, 0, 0, 0, 0, 0, 0, 0}, kl = kh;
            if (rowok) {
                const f32x4 a0 = *(const f32x4*)(kp0 + 16 * jj), a1 = *(const f32x4*)(kp0 + 16 * jj + 4);
                const f32x4 c0 = *(const f32x4*)(kp0 + 2048 + 16 * jj), c1 = *(const f32x4*)(kp0 + 2048 + 16 * jj + 4);
                const f32x4 m0 = (a0 + c0) * (1.0f / 256.0f), m1 = (a1 + c1) * (1.0f / 256.0f);
                u32x4 hi, lo;
                hi.x = cvtpk(m0[0], m0[1]); hi.y = cvtpk(m0[2], m0[3]); hi.z = cvtpk(m1[0], m1[1]); hi.w = cvtpk(m1[2], m1[3]);
                lo.x = cvtpk(m0[0] - bflo(hi.x), m0[1] - bfhi(hi.x)); lo.y = cvtpk(m0[2] - bflo(hi.y), m0[3] - bfhi(hi.y));
                lo.z = cvtpk(m1[0] - bflo(hi.z), m1[1] - bfhi(hi.z)); lo.w = cvtpk(m1[2] - bflo(hi.w), m1[3] - bfhi(hi.w));
                kh = __builtin_bit_cast(bf16x8, hi); kl = __builtin_bit_cast(bf16x8, lo);
            }
            G = MFMA32(kh, qf[jj], G); G = MFMA32(kl, qf[jj], G);
        }
#pragma unroll
        for (int pick = 0; pick < 3; ++pick) {
            float best = -INFINITY; int bi = -1;
#pragma unroll
            for (int i = 0; i < 16; ++i) { const bool ok = (i < n) && !((sel >> i) & 1u) && (G[i] > best); best = ok ? G[i] : best; bi = ok ? i : bi; }
            if (bi >= 0) sel |= 1u << bi;
        }
        sel = (unsigned)__shfl((int)sel, ql);
    }
    unsigned uni = sel;
#pragma unroll
    for (int o = 1; o < 32; o <<= 1) uni |= (unsigned)__shfl_xor((int)uni, o);
    uni = (unsigned)__builtin_amdgcn_readfirstlane((int)uni);
    float m_run = -1e30f, l_run = 0.f; f32x16 o0, o1;
#pragma unroll
    for (int i = 0; i < 16; ++i) { o0[i] = 0.f; o1[i] = 0.f; }
    const bf16_t* kbase = QKV + (size_t)(b * SEQ + pi32(ql)) * LD1 + 2048 + hh * 64 + 8 * h;
    const bf16_t* vbase = VT + ((size_t)((b * 32 + hh) * 64 + ql) << 12) + 8 * h;
#pragma unroll 1
    for (int blk = 0; blk <= n; ++blk) {
        const bool own = (blk == n);
        if (!own && !((uni >> blk) & 1u)) continue;
        const bool mine = own || ((sel >> blk) & 1u);
        const int ntile = own ? sub + 1 : 8;
#pragma unroll 1
        for (int kt8 = 0; kt8 < ntile; ++kt8) {
            const int key0 = 256 * blk + 32 * kt8;
            const bf16_t* kp = kbase + (size_t)key0 * LD1;
            bf16x8 kf[4];
#pragma unroll
            for (int jj = 0; jj < 4; ++jj) kf[jj] = *(const bf16x8*)(kp + 16 * jj);
            const bf16_t* vp = vbase + key0;
            const bf16x8 v00 = *(const bf16x8*)(vp), v01 = *(const bf16x8*)(vp + 16);
            const bf16x8 v10 = *(const bf16x8*)(vp + ((size_t)32 << 12)), v11 = *(const bf16x8*)(vp + ((size_t)32 << 12) + 16);
            f32x16 s;
#pragma unroll
            for (int i = 0; i < 16; ++i) s[i] = 0.f;
#pragma unroll
            for (int jj = 0; jj < 4; ++jj) s = MFMA32(kf[jj], qf[jj], s);
            const bool diag = own && (kt8 == sub);
#pragma unroll
            for (int i = 0; i < 16; ++i) { const bool ok = mine && (!diag || kofs(i, h) <= ql); s[i] = ok ? s[i] * C : -INFINITY; }
            softmax_pv(s, m_run, l_run, o0, o1, v00, v01, v10, v11);
        }
    }
    const float l = l_run + __shfl_xor(l_run, 32);
    store_o64(AO + (size_t)(b * SEQ + tq) * DM + hh * 64, o0, o1, 1.0f / l, h);
}

#define LBAR() do { asm volatile("s_waitcnt lgkmcnt(0)" ::: "memory"); __builtin_amdgcn_s_barrier(); asm volatile("" ::: "memory"); } while (0)
DI void moba_unit(int b, int hh, int n, const bf16_t* QKV, const bf16_t* VT, const bf16_t* KMH, const bf16_t* KML, bf16_t* AO,
                  LAS unsigned char* lds, int tid, int wave, int lane) {
    const int ql = lane & 31, h = lane >> 5;
    const float C = 0.125f * 1.4426950408889634f;
    const int qin = 32 * wave + ql, tq = 256 * n + qin;
    const int lrow = tid >> 3, lch = tid & 7;
    const bf16_t* kgb = QKV + (size_t)(b * SEQ) * LD1 + 2048 + hh * 64;
    const bf16_t* vgb = VT + ((size_t)((b * 32 + hh) * 64) << 12);
    const unsigned kgo = (unsigned)(lrow * LD1 + 8 * lch), vgo = (unsigned)((lrow << 12) + 8 * lch);
    LAS unsigned char* kw = lds + lrow * 144 + lch * 16;
    LAS unsigned char* vw = kw + 36864;
    const LAS unsigned char* kr = lds + pi32(ql) * 144 + 16 * h;
    const LAS unsigned char* vr = lds + 36864 + ql * 144 + 16 * h;
#define LD_TILE(T, RK, RV) do { const int key0_ = 64 * (T); RK = *(const bf16x8*)(kgb + (size_t)key0_ * LD1 + kgo); RV = *(const bf16x8*)(vgb + key0_ + vgo); } while (0)
#define ST_TILE(buf, RK, RV) do { *(LAS bf16x8*)(kw + (buf) * 9216) = RK; *(LAS bf16x8*)(vw + (buf) * 9216) = RV; } while (0)
    const int ntiles = 4 * (n + 1);
    bf16x8 rkA, rvA, rkB, rvB;
    LD_TILE(0, rkA, rvA); LD_TILE(1, rkB, rvB);
    const bf16_t* qp = QKV + (size_t)(b * SEQ + tq) * LD1 + hh * 64 + 8 * h;
    bf16x8 qf[4];
#pragma unroll
    for (int jj = 0; jj < 4; ++jj) qf[jj] = *(const bf16x8*)(qp + 16 * jj);
    unsigned sel = 0u;
    if (n > 0) {
        const int blk = (ql & 3) + 4 * (ql >> 3);
        const bool rowok = ((ql & 4) == 0);
        const float* kp0 = (const float*)KMH + ((size_t)((b * 16 + blk) * 2) * 2048) + hh * 64 + 8 * h;
        f32x16 Gt;
#pragma unroll
        for (int i = 0; i < 16; ++i) Gt[i] = 0.f;
#pragma unroll
        for (int jj = 0; jj < 4; ++jj) {
            bf16x8 kh = (bf16x8){0, 0, 0, 0, 0, 0, 0, 0}, kl = kh;
            if (rowok) {
                const f32x4 a0 = *(const f32x4*)(kp0 + 16 * jj), a1 = *(const f32x4*)(kp0 + 16 * jj + 4);
                const f32x4 c0 = *(const f32x4*)(kp0 + 2048 + 16 * jj), c1 = *(const f32x4*)(kp0 + 2048 + 16 * jj + 4);
                const f32x4 m0 = (a0 + c0) * (1.0f / 256.0f), m1 = (a1 + c1) * (1.0f / 256.0f);
                u32x4 hi, lo;
                hi.x = cvtpk(m0[0], m0[1]); hi.y = cvtpk(m0[2], m0[3]); hi.z = cvtpk(m1[0], m1[1]); hi.w = cvtpk(m1[2], m1[3]);
                lo.x = cvtpk(m0[0] - bflo(hi.x), m0[1] - bfhi(hi.x)); lo.y = cvtpk(m0[2] - bflo(hi.y), m0[3] - bfhi(hi.y));
                lo.z = cvtpk(m1[0] - bflo(hi.z), m1[1] - bfhi(hi.z)); lo.w = cvtpk(m1[2] - bflo(hi.w), m1[3] - bfhi(hi.w));
                kh = __builtin_bit_cast(bf16x8, hi); kl = __builtin_bit_cast(bf16x8, lo);
            }
            Gt = MFMA32(kh, qf[jj], Gt); Gt = MFMA32(kl, qf[jj], Gt);
        }
#pragma unroll
        for (int pick = 0; pick < 3; ++pick) {
            float best = -INFINITY; int bi = -1;
#pragma unroll
            for (int i = 0; i < 16; ++i) { const bool ok = (i < n) && !((sel >> i) & 1u) && (Gt[i] > best); best = ok ? Gt[i] : best; bi = ok ? i : bi; }
            if (bi >= 0) sel |= 1u << bi;
        }
        sel = (unsigned)__shfl((int)sel, ql);
    }
    unsigned uni = sel;
#pragma unroll
    for (int o = 1; o < 32; o <<= 1) uni |= (unsigned)__shfl_xor((int)uni, o);
    uni = (unsigned)__builtin_amdgcn_readfirstlane((int)uni);
    float m_run = -1e30f, l_run = 0.f; f32x16 o0, o1;
#pragma unroll
    for (int i = 0; i < 16; ++i) { o0[i] = 0.f; o1[i] = 0.f; }
#define MOBA_KLD(koff, KF) do { const LAS unsigned char* kb_ = kr + (koff); \
        _Pragma("unroll") for (int jj = 0; jj < 4; ++jj) { KF[2 * jj] = *(const LAS bf16x8*)(kb_ + jj * 32); KF[2 * jj + 1] = *(const LAS bf16x8*)(kb_ + 32 * 144 + jj * 32); } } while (0)
#define MOBA_VLD(voff, VF) do { const LAS unsigned char* vb_ = vr + (voff); \
        VF[0] = *(const LAS bf16x8*)(vb_); VF[1] = *(const LAS bf16x8*)(vb_ + 32); VF[2] = *(const LAS bf16x8*)(vb_ + 64); VF[3] = *(const LAS bf16x8*)(vb_ + 96); \
        VF[4] = *(const LAS bf16x8*)(vb_ + 32 * 144); VF[5] = *(const LAS bf16x8*)(vb_ + 32 * 144 + 32); VF[6] = *(const LAS bf16x8*)(vb_ + 32 * 144 + 64); VF[7] = *(const LAS bf16x8*)(vb_ + 32 * 144 + 96); } while (0)
#define MOBA_QK(KF, S0, S1) do { \
        _Pragma("unroll") for (int i = 0; i < 16; ++i) { S0[i] = 0.f; S1[i] = 0.f; } \
        _Pragma("unroll") for (int jj = 0; jj < 4; ++jj) { S0 = MFMA32(KF[2 * jj], qf[jj], S0); S1 = MFMA32(KF[2 * jj + 1], qf[jj], S1); } } while (0)
#define MOBA_SMPV(T, VF, s0_, s1_) do { \
        const int blk_ = (T) >> 2, kt_ = (T) & 3; const bool own_ = (blk_ == n); \
        const bool act_ = own_ ? (64 * kt_ <= 32 * wave + 31) : (((uni >> blk_) & 1u) != 0u); \
        if (act_) { \
            const bool mine_ = own_ || (((sel >> blk_) & 1u) != 0u); \
            float mnew_; \
            if (own_ && (64 * kt_ + 63 > 32 * wave)) {              \
                const int lim_ = qin - 64 * kt_ - 8 * h; \
                _Pragma("unroll") for (int i = 0; i < 16; ++i) { \
                    const int kc_ = 16 * (i >> 3) + (i & 7); \
                    s0_[i] = (kc_ <= lim_) ? s0_[i] * C : -INFINITY; s1_[i] = (kc_ + 32 <= lim_) ? s1_[i] * C : -INFINITY; } \
                float mx_ = fmaxf(s0_[0], s1_[0]); \
                _Pragma("unroll") for (int i = 1; i < 16; ++i) mx_ = fmaxf(fmaxf(mx_, s0_[i]), s1_[i]); \
                mx_ = xhalf_max(mx_); \
                mnew_ = fmaxf(m_run, mx_); \
                _Pragma("unroll") for (int i = 0; i < 16; ++i) { s0_[i] = fexp2(s0_[i] - mnew_); s1_[i] = fexp2(s1_[i] - mnew_); } \
            } else {                                                \
                float mx_ = fmaxf(s0_[0], s1_[0]); \
                _Pragma("unroll") for (int i = 1; i < 16; ++i) mx_ = fmaxf(fmaxf(mx_, s0_[i]), s1_[i]); \
                mx_ = mine_ ? mx_ * C : -INFINITY; \
                mx_ = xhalf_max(mx_); \
                mnew_ = fmaxf(m_run, mx_); \
                const float nb_ = mine_ ? -mnew_ : -INFINITY; \
                s0_ = s0_ * C + nb_; s1_ = s1_ * C + nb_; \
                _Pragma("unroll") for (int i = 0; i < 16; ++i) { s0_[i] = fexp2(s0_[i]); s1_[i] = fexp2(s1_[i]); } \
            } \
            const float alpha_ = fexp2(m_run - mnew_); m_run = mnew_; \
            const f32x16 ps_ = s0_ + s1_; \
            const float sum_ = ((ps_[0] + ps_[1]) + (ps_[2] + ps_[3])) + ((ps_[4] + ps_[5]) + (ps_[6] + ps_[7])) + ((ps_[8] + ps_[9]) + (ps_[10] + ps_[11])) + ((ps_[12] + ps_[13]) + (ps_[14] + ps_[15])); \
            l_run = l_run * alpha_ + sum_; \
            if (__any(alpha_ != 1.0f)) { o0 = o0 * alpha_; o1 = o1 * alpha_; } \
            const bf16x8 p00_ = pack8(s0_, 0), p01_ = pack8(s0_, 1), p10_ = pack8(s1_, 0), p11_ = pack8(s1_, 1); \
            o0 = MFMA32(VF[0], p00_, o0); o0 = MFMA32(VF[1], p01_, o0); o0 = MFMA32(VF[2], p10_, o0); o0 = MFMA32(VF[3], p11_, o0); \
            o1 = MFMA32(VF[4], p00_, o1); o1 = MFMA32(VF[5], p01_, o1); o1 = MFMA32(VF[6], p10_, o1); o1 = MFMA32(VF[7], p11_, o1); \
        } } while (0)
    asm volatile("" :: "v"(qf[0]), "v"(qf[1]), "v"(qf[2]), "v"(qf[3]));
    const int lastT = ntiles - 1;
#define MOBA_PAIR(T, offA, offB) do { \
        const int blk_ = (T) >> 2; \
        if (((uni >> blk_) & 1u) != 0u) { \
            const bool mine_ = (((sel >> blk_) & 1u) != 0u); \
            const LAS unsigned char* ka_ = kr + (offA); const LAS unsigned char* kb_ = kr + (offB); \
            f32x16 a0_, a1_, b0_, b1_; \
            _Pragma("unroll") for (int i = 0; i < 16; ++i) { a0_[i] = 0.f; a1_[i] = 0.f; b0_[i] = 0.f; b1_[i] = 0.f; } \
            _Pragma("unroll") for (int jj = 0; jj < 4; ++jj) { \
                a0_ = MFMA32(*(const LAS bf16x8*)(ka_ + jj * 32), qf[jj], a0_); b0_ = MFMA32(*(const LAS bf16x8*)(kb_ + jj * 32), qf[jj], b0_); \
                a1_ = MFMA32(*(const LAS bf16x8*)(ka_ + 32 * 144 + jj * 32), qf[jj], a1_); b1_ = MFMA32(*(const LAS bf16x8*)(kb_ + 32 * 144 + jj * 32), qf[jj], b1_); } \
            float mxa_ = fmaxf(a0_[0], a1_[0]), mxb_ = fmaxf(b0_[0], b1_[0]); \
            _Pragma("unroll") for (int i = 1; i < 16; ++i) { mxa_ = fmaxf(fmaxf(mxa_, a0_[i]), a1_[i]); mxb_ = fmaxf(fmaxf(mxb_, b0_[i]), b1_[i]); } \
            float mx_ = fmaxf(mxa_, mxb_); \
            mx_ = mine_ ? mx_ * C : -INFINITY; \
            mx_ = xhalf_max(mx_); \
            const float mnew_ = fmaxf(m_run, mx_); \
            const float nb_ = mine_ ? -mnew_ : -INFINITY; \
            a0_ = a0_ * C + nb_; b0_ = b0_ * C + nb_; a1_ = a1_ * C + nb_; b1_ = b1_ * C + nb_; \
            _Pragma("unroll") for (int i = 0; i < 16; ++i) { a0_[i] = fexp2(a0_[i]); b0_[i] = fexp2(b0_[i]); a1_[i] = fexp2(a1_[i]); b1_[i] = fexp2(b1_[i]); } \
            const float alpha_ = fexp2(m_run - mnew_); m_run = mnew_; \
            const f32x16 ps_ = (a0_ + a1_) + (b0_ + b1_); \
            const float sum_ = ((ps_[0] + ps_[1]) + (ps_[2] + ps_[3])) + ((ps_[4] + ps_[5]) + (ps_[6] + ps_[7])) + ((ps_[8] + ps_[9]) + (ps_[10] + ps_[11])) + ((ps_[12] + ps_[13]) + (ps_[14] + ps_[15])); \
            l_run = l_run * alpha_ + sum_; \
            if (__any(alpha_ != 1.0f)) { o0 = o0 * alpha_; o1 = o1 * alpha_; } \
            const LAS unsigned char* va_ = vr + (offA); const LAS unsigned char* vb_ = vr + (offB); \
            { const bf16x8 p_ = pack8(a0_, 0); o0 = MFMA32(*(const LAS bf16x8*)(va_), p_, o0); o1 = MFMA32(*(const LAS bf16x8*)(va_ + 32 * 144), p_, o1); } \
            { const bf16x8 p_ = pack8(a0_, 1); o0 = MFMA32(*(const LAS bf16x8*)(va_ + 32), p_, o0); o1 = MFMA32(*(const LAS bf16x8*)(va_ + 32 * 144 + 32), p_, o1); } \
            { const bf16x8 p_ = pack8(a1_, 0); o0 = MFMA32(*(const LAS bf16x8*)(va_ + 64), p_, o0); o1 = MFMA32(*(const LAS bf16x8*)(va_ + 32 * 144 + 64), p_, o1); } \
            { const bf16x8 p_ = pack8(a1_, 1); o0 = MFMA32(*(const LAS bf16x8*)(va_ + 96), p_, o0); o1 = MFMA32(*(const LAS bf16x8*)(va_ + 32 * 144 + 96), p_, o1); } \
            { const bf16x8 p_ = pack8(b0_, 0); o0 = MFMA32(*(const LAS bf16x8*)(vb_), p_, o0); o1 = MFMA32(*(const LAS bf16x8*)(vb_ + 32 * 144), p_, o1); } \
            { const bf16x8 p_ = pack8(b0_, 1); o0 = MFMA32(*(const LAS bf16x8*)(vb_ + 32), p_, o0); o1 = MFMA32(*(const LAS bf16x8*)(vb_ + 32 * 144 + 32), p_, o1); } \
            { const bf16x8 p_ = pack8(b1_, 0); o0 = MFMA32(*(const LAS bf16x8*)(vb_ + 64), p_, o0); o1 = MFMA32(*(const LAS bf16x8*)(vb_ + 32 * 144 + 64), p_, o1); } \
            { const bf16x8 p_ = pack8(b1_, 1); o0 = MFMA32(*(const LAS bf16x8*)(vb_ + 96), p_, o0); o1 = MFMA32(*(const LAS bf16x8*)(vb_ + 32 * 144 + 96), p_, o1); } \
        } } while (0)
#define MOBA_ONE(T, off) do { f32x16 s0_, s1_; bf16x8 kf_[8]; MOBA_KLD(off, kf_); MOBA_QK(kf_, s0_, s1_); \
        { bf16x8 vf_[8]; MOBA_VLD(off, vf_); MOBA_SMPV(T, vf_, s0_, s1_); } } while (0)
    ST_TILE(0, rkA, rvA); ST_TILE(1, rkB, rvB);
    LD_TILE(2, rkA, rvA); LD_TILE(3, rkB, rvB);
    LBAR();
    int pc = 0;
#pragma unroll 1
    for (int T = 0; T < ntiles; T += 2) {
        if ((T >> 2) < n) { MOBA_PAIR(T, pc, pc + 9216); }
        else { MOBA_ONE(T, pc); MOBA_ONE(T + 1, pc + 9216); }
        const int pnx = pc ^ 18432;
        *(LAS bf16x8*)(kw + pnx) = rkA; *(LAS bf16x8*)(vw + pnx) = rvA; *(LAS bf16x8*)(kw + pnx + 9216) = rkB; *(LAS bf16x8*)(vw + pnx + 9216) = rvB;
        { const int Ta = (T + 4 < lastT) ? T + 4 : lastT, Tb = (T + 5 < lastT) ? T + 5 : lastT; LD_TILE(Ta, rkA, rvA); LD_TILE(Tb, rkB, rvB); }
        LBAR();
        pc = pnx;
    }
#undef MOBA_PAIR
#undef MOBA_ONE
#define MOBA_ROT() do {} while (0)
#undef MOBA_ROT
#undef MOBA_QK
#undef MOBA_KLD
#undef MOBA_VLD
#undef MOBA_SMPV
#define MOBA_COMPUTE_UNUSED
#undef MOBA_COMPUTE_UNUSED
#undef LD_TILE
#undef ST_TILE
    const float l = l_run + __shfl_xor(l_run, 32);
    store_o64(AO + (size_t)(b * SEQ + tq) * DM + hh * 64, o0, o1, 1.0f / l, h);
}

DI void xattn_item(int item, const bf16_t* QX, const bf16_t* MK, const bf16_t* MVT, bf16_t* AO, int lane) {
    const int qs = item & 127, hx = (item >> 7) & 3, b = item >> 9;
    const int ql = lane & 31, h = lane >> 5;
    const float C = 0.04419417382415922f * 1.4426950408889634f;
    const int tq = 32 * qs + ql;
    const bf16_t* qp = QX + (size_t)(b * SEQ + tq) * DM + hx * 512 + 8 * h;
    const bf16_t* kp = MK + (size_t)(b * 256 + pi32(ql)) * DM + hx * 512 + 8 * h;
    f32x16 S[8];
#pragma unroll
    for (int kt = 0; kt < 8; ++kt)
#pragma unroll
        for (int i = 0; i < 16; ++i) S[kt][i] = 0.f;
#pragma unroll 2
    for (int jj = 0; jj < 32; ++jj) {
        const bf16x8 qf = *(const bf16x8*)(qp + 16 * jj);
#pragma unroll
        for (int kt = 0; kt < 8; ++kt) {
            const bf16x8 kf = *(const bf16x8*)(kp + (size_t)(32 * kt) * DM + 16 * jj);
            S[kt] = MFMA32(kf, qf, S[kt]);
        }
    }
    float mx = S[0][0];
#pragma unroll
    for (int kt = 0; kt < 8; ++kt)
#pragma unroll
        for (int i = 0; i < 16; ++i) mx = fmaxf(mx, S[kt][i]);
    mx = fmaxf(mx, __shfl_xor(mx, 32));
    const float mc = mx * C;
    float sum = 0.f;
    bf16x8 pb[8][2];
#pragma unroll
    for (int kt = 0; kt < 8; ++kt) {
#pragma unroll
        for (int i = 0; i < 16; ++i) { S[kt][i] = fexp2(S[kt][i] * C - mc); sum += S[kt][i]; }
        pb[kt][0] = pack8(S[kt], 0); pb[kt][1] = pack8(S[kt], 1);
    }
    sum += __shfl_xor(sum, 32);
    const float inv = 1.0f / sum;
    const bf16_t* vp = MVT + ((size_t)((b * 4 + hx) * 512 + ql) << 8) + 8 * h;
    bf16_t* orow = AO + (size_t)(b * SEQ + tq) * DM + hx * 512 + 4 * h;
#pragma unroll 1
    for (int dt = 0; dt < 16; ++dt) {
        f32x16 acc;
#pragma unroll
        for (int i = 0; i < 16; ++i) acc[i] = 0.f;
        const bf16_t* vr = vp + ((size_t)(32 * dt) << 8);
#pragma unroll
        for (int kt = 0; kt < 8; ++kt) {
            const bf16x8 v0 = *(const bf16x8*)(vr + 32 * kt), v1 = *(const bf16x8*)(vr + 32 * kt + 16);
            acc = MFMA32(v0, pb[kt][0], acc); acc = MFMA32(v1, pb[kt][1], acc);
        }
#pragma unroll
        for (int g4 = 0; g4 < 4; ++g4) {
            u32x2 w; w.x = cvtpk(acc[4 * g4] * inv, acc[4 * g4 + 1] * inv); w.y = cvtpk(acc[4 * g4 + 2] * inv, acc[4 * g4 + 3] * inv);
            *(u32x2*)(orow + 32 * dt + 8 * g4) = w;
        }
    }
}

DI void xattn_unit(int unit, const bf16_t* QX, const bf16_t* MK, const bf16_t* MVT, bf16_t* AOp, LAS unsigned char* lds, int tid, int wave, int lane) {
    constexpr int BUFB = 36864;
    const int qb = unit & 15, hx = (unit >> 4) & 3, b = unit >> 6;
    const int ql = lane & 31, h = lane >> 5;
    const float C = 0.04419417382415922f * 1.4426950408889634f;
    const int tq = 256 * qb + 32 * wave + ql;
    const bf16_t* kg = MK + (size_t)(b * 256 + (tid >> 1)) * DM + hx * 512 + 32 * (tid & 1);
    const bf16_t* vg = MVT + ((size_t)((b * 4 + hx) * 512 + (tid >> 3)) << 8) + 32 * (tid & 7);
    LAS unsigned char* kw = lds + (tid >> 1) * 144 + (tid & 1) * 64;
    LAS unsigned char* vw = lds + (tid >> 3) * 528 + (tid & 7) * 64;
    const LAS unsigned char* kr = lds + pi32(ql) * 144 + 16 * h;
    const LAS unsigned char* vr = lds + ql * 528 + 16 * h;
    const bf16_t* qp = QX + (size_t)(b * SEQ + tq) * DM + hx * 512 + 8 * h;
    bf16_t* orow = AOp + (size_t)(b * SEQ + tq) * DM + hx * 512 + 4 * h;
#define XLD(T, R) do { if ((T) < 8) { _Pragma("unroll") for (int i_ = 0; i_ < 4; ++i_) R[i_] = *(const bf16x8*)(kg + 64 * (T) + 8 * i_); } \
                       else { _Pragma("unroll") for (int i_ = 0; i_ < 4; ++i_) R[i_] = *(const bf16x8*)(vg + ((size_t)(64 * ((T) - 8)) << 8) + 8 * i_); } } while (0)
#define XST(T, buf, R) do { if ((T) < 8) { _Pragma("unroll") for (int i_ = 0; i_ < 4; ++i_) *(LAS bf16x8*)(kw + (buf) * BUFB + 16 * i_) = R[i_]; } \
                            else { _Pragma("unroll") for (int i_ = 0; i_ < 4; ++i_) *(LAS bf16x8*)(vw + (buf) * BUFB + 16 * i_) = R[i_]; } } while (0)
    bf16x8 RA[4], RB[4], qf[4];
    f32x16 S[8];
    bf16x8 pb[8][2];
    float inv = 0.f;
#pragma unroll
    for (int kt = 0; kt < 8; ++kt)
#pragma unroll
        for (int i = 0; i < 16; ++i) S[kt][i] = 0.f;
    XLD(0, RA); XLD(1, RB);
#pragma unroll
    for (int jj = 0; jj < 4; ++jj) qf[jj] = *(const bf16x8*)(qp + 16 * jj);
    XST(0, 0, RA); XLD(2, RA);
    LBAR();
#define XCOMP(T, buf) do { \
        if ((T) < 8) { \
            _Pragma("unroll") for (int jj = 0; jj < 4; ++jj) \
                _Pragma("unroll") for (int kt = 0; kt < 8; ++kt) { \
                    const bf16x8 kf_ = *(const LAS bf16x8*)(kr + (buf) * BUFB + (32 * kt) * 144 + jj * 32); \
                    S[kt] = MFMA32(kf_, qf[jj], S[kt]); } \
            if ((T) + 1 < 8) { _Pragma("unroll") for (int jj = 0; jj < 4; ++jj) qf[jj] = *(const bf16x8*)(qp + 64 * ((T) + 1) + 16 * jj); } \
            if ((T) == 7) { \
                float mx_ = S[0][0]; \
                _Pragma("unroll") for (int kt = 0; kt < 8; ++kt) _Pragma("unroll") for (int i = 0; i < 16; ++i) mx_ = fmaxf(mx_, S[kt][i]); \
                mx_ = xhalf_max(mx_); \
                const float mc_ = -mx_ * C; float sum_ = 0.f; \
                _Pragma("unroll") for (int kt = 0; kt < 8; ++kt) { \
                    S[kt] = S[kt] * C + mc_; \
                    _Pragma("unroll") for (int i = 0; i < 16; ++i) { S[kt][i] = fexp2(S[kt][i]); sum_ += S[kt][i]; } \
                    pb[kt][0] = pack8(S[kt], 0); pb[kt][1] = pack8(S[kt], 1); } \
                sum_ += __shfl_xor(sum_, 32); inv = 1.0f / sum_; } \
        } else { \
            _Pragma("unroll") for (int dt2 = 0; dt2 < 2; ++dt2) { \
                f32x16 acc_; \
                _Pragma("unroll") for (int i = 0; i < 16; ++i) acc_[i] = 0.f; \
                _Pragma("unroll") for (int kt = 0; kt < 8; ++kt) { \
                    const bf16x8 v0_ = *(const LAS bf16x8*)(vr + (buf) * BUFB + (32 * dt2) * 528 + 64 * kt); \
                    const bf16x8 v1_ = *(const LAS bf16x8*)(vr + (buf) * BUFB + (32 * dt2) * 528 + 64 * kt + 32); \
                    acc_ = MFMA32(v0_, pb[kt][0], acc_); acc_ = MFMA32(v1_, pb[kt][1], acc_); } \
                _Pragma("unroll") for (int g4 = 0; g4 < 4; ++g4) { \
                    u32x2 w_; w_.x = cvtpk(acc_[4 * g4] * inv, acc_[4 * g4 + 1] * inv); w_.y = cvtpk(acc_[4 * g4 + 2] * inv, acc_[4 * g4 + 3] * inv); \
                    *(u32x2*)(orow + 64 * ((T) - 8) + 32 * dt2 + 8 * g4) = w_; } } \
        } } while (0)
#define XSTEP2(T) do { \
        XCOMP((T), 0); XST((T) + 1, 1, RB); if ((T) + 3 < 16) XLD((T) + 3, RB); LBAR(); \
        XCOMP((T) + 1, 1); if ((T) + 2 < 16) { XST((T) + 2, 0, RA); if ((T) + 4 < 16) XLD((T) + 4, RA); } LBAR(); } while (0)
    XSTEP2(0); XSTEP2(2); XSTEP2(4); XSTEP2(6); XSTEP2(8); XSTEP2(10); XSTEP2(12); XSTEP2(14);
#undef XSTEP2
#undef XCOMP
#undef XLD
#undef XST
}

DI void ln_rows(const float* y, float* xo, bf16_t* xb, f32x2* stats, const float* gam, const float* bet, int gw, int ngw, int lane) {
    if (gw == 0) {
        f32x4* lg = (f32x4*)((char*)stats + (WS_LNG - WS_STATS)); f32x4* lb = (f32x4*)((char*)stats + (WS_LNB - WS_STATS));
#pragma unroll
        for (int j = 0; j < 8; ++j) { lg[lane + 64 * j] = ((const f32x4*)gam)[lane + 64 * j]; lb[lane + 64 * j] = ((const f32x4*)bet)[lane + 64 * j]; }
    }
    f32x4 gq[8], bq[8];
#pragma unroll
    for (int j = 0; j < 8; ++j) { gq[j] = ((const f32x4*)gam)[lane + 64 * j]; bq[j] = ((const f32x4*)bet)[lane + 64 * j]; }
    for (int row = gw; row < TOK; row += 2 * ngw) {
        const int row2 = row + ngw;
        const bool has2 = row2 < TOK;
        const f32x4* yr = (const f32x4*)(y + (size_t)row * DM) + lane;
        const f32x4* yr2 = (const f32x4*)(y + (size_t)(has2 ? row2 : row) * DM) + lane;
        f32x4 v[8], w[8]; float s = 0.f, t = 0.f;
#pragma unroll
        for (int j = 0; j < 8; ++j) { v[j] = yr[64 * j]; w[j] = yr2[64 * j]; }
#pragma unroll
        for (int j = 0; j < 8; ++j) { s += (v[j][0] + v[j][1]) + (v[j][2] + v[j][3]); t += (w[j][0] + w[j][1]) + (w[j][2] + w[j][3]); }
        const float mean = wave_sum(s) * (1.0f / DM), mean2 = wave_sum(t) * (1.0f / DM);
        float s2 = 0.f, t2 = 0.f;
#pragma unroll
        for (int j = 0; j < 8; ++j) { v[j] = v[j] - mean; s2 += (v[j][0] * v[j][0] + v[j][1] * v[j][1]) + (v[j][2] * v[j][2] + v[j][3] * v[j][3]);
                                      w[j] = w[j] - mean2; t2 += (w[j][0] * w[j][0] + w[j][1] * w[j][1]) + (w[j][2] * w[j][2] + w[j][3] * w[j][3]); }
        const float rstd = 1.0f / sqrtf(wave_sum(s2) * (1.0f / DM) + LN_EPS), rstd2 = 1.0f / sqrtf(wave_sum(t2) * (1.0f / DM) + LN_EPS);
        if (xb && lane == 0) { stats[row] = (f32x2){mean, rstd}; if (has2) stats[row2] = (f32x2){mean2, rstd2}; }
        u32x2* br = (u32x2*)(xb + (size_t)row * DM) + lane;
        u32x2* br2 = (u32x2*)(xb + (size_t)row2 * DM) + lane;
#pragma unroll
        for (int j = 0; j < 8; ++j) {
            const f32x4 g = gq[j], bb = bq[j];
            const f32x4 o = v[j] * rstd * g + bb, o2 = w[j] * rstd2 * g + bb;
            if (xo) { ((f32x4*)(xo + (size_t)row * DM) + lane)[64 * j] = o; if (has2) ((f32x4*)(xo + (size_t)row2 * DM) + lane)[64 * j] = o2; }
            if (xb) { u32x2 p; p.x = cvtpk(o[0], o[1]); p.y = cvtpk(o[2], o[3]); br[64 * j] = p;
            if (has2) { u32x2 q; q.x = cvtpk(o2[0], o2[1]); q.y = cvtpk(o2[2], o2[3]); br2[64 * j] = q; } }
        }
    }
}

DI void transpose_item(const float* W, int K, int N, bf16_t* WT, int mode, LAS float* scr, int item, int lane) {
    const int nblk = N / 32, kb = item / nblk, nb = item - kb * nblk, k0 = 64 * kb, n0 = 32 * nb;
    int drow0 = n0;
    const float wsc = (mode == 1) ? (n0 < DFF ? 1.4426950408889634f : 0.6931471805599453f) : 1.0f;
    if (mode == 1) { if (n0 < DFF) drow0 = (n0 >> 7) * 256 + (n0 & 127); else { const int n1 = n0 - DFF; drow0 = (n1 >> 7) * 256 + 128 + (n1 & 127); } }
    const float* src = W + (size_t)(k0 + (lane >> 5)) * N + n0 + (lane & 31);
#pragma unroll 16
    for (int i = 0; i < 32; ++i) scr[(2 * i + (lane >> 5)) * 33 + (lane & 31)] = src[(size_t)(2 * i) * N];
    asm volatile("s_waitcnt lgkmcnt(0)" ::: "memory");
    const int c = lane & 7;
#pragma unroll
    for (int j = 0; j < 4; ++j) {
        const int n = (lane >> 3) + 8 * j; const LAS float* s = scr + (8 * c) * 33 + n;
        u32x4 o; o.x = cvtpk(s[0 * 33] * wsc, s[1 * 33] * wsc); o.y = cvtpk(s[2 * 33] * wsc, s[3 * 33] * wsc); o.z = cvtpk(s[4 * 33] * wsc, s[5 * 33] * wsc); o.w = cvtpk(s[6 * 33] * wsc, s[7 * 33] * wsc);
        *(u32x4*)(WT + (size_t)(drow0 + n) * K + k0 + 8 * c) = o;
    }
    asm volatile("s_waitcnt lgkmcnt(0)" ::: "memory");
}
DI void cvt_rows(const float* src, bf16_t* dst, size_t n8, int gt, int ngt) {
    size_t i = gt;
    for (; i + 3 * (size_t)ngt < n8; i += 4 * (size_t)ngt) {
        f32x4 a[4], b[4];
#pragma unroll
        for (int u = 0; u < 4; ++u) { a[u] = ((const f32x4*)src)[2 * (i + u * (size_t)ngt)]; b[u] = ((const f32x4*)src)[2 * (i + u * (size_t)ngt) + 1]; }
#pragma unroll
        for (int u = 0; u < 4; ++u) { u32x4 w; w.x = cvtpk(a[u][0], a[u][1]); w.y = cvtpk(a[u][2], a[u][3]); w.z = cvtpk(b[u][0], b[u][1]); w.w = cvtpk(b[u][2], b[u][3]); ((u32x4*)dst)[i + u * (size_t)ngt] = w; }
    }
    for (; i < n8; i += ngt) {
        const f32x4 a = ((const f32x4*)src)[2 * i], b = ((const f32x4*)src)[2 * i + 1];
        u32x4 w; w.x = cvtpk(a[0], a[1]); w.y = cvtpk(a[2], a[3]); w.z = cvtpk(b[0], b[1]); w.w = cvtpk(b[2], b[3]);
        ((u32x4*)dst)[i] = w;
    }
}

#define XB_TMO      128
#define XB_XCNT(j)  (256  + 64 * (j))
#define XB_XSUB(j)  (1280 + 64 * (j))
#define XB_XGEN(j)  (2304 + 64 * (j))
#define XB_TOP      3328
#define XB_TOPGEN   3392
#define XCD_BAR_WORDS 3456
#define XB_SPIN_CAP (1u << 22)
DI unsigned xb_ld(unsigned* p)              { return __hip_atomic_load(p, __ATOMIC_RELAXED, __HIP_MEMORY_SCOPE_AGENT); }
DI unsigned xb_add(unsigned* p, unsigned v) { return __hip_atomic_fetch_add(p, v, __ATOMIC_RELAXED, __HIP_MEMORY_SCOPE_AGENT); }
DI unsigned xb_xcc_id() { return (unsigned)__builtin_amdgcn_s_getreg((3 << 11) | 20) & 0xFu; }
#define XB_SPIN(cond, bar) do { unsigned _sp = 0; while (cond) { __builtin_amdgcn_s_sleep(1); \
    if ((++_sp & 255u) == 0u) { if (xb_ld(&(bar)[XB_TMO])) break; if (_sp > XB_SPIN_CAP) { atomicAdd(&(bar)[XB_TMO], 1u); break; } } } } while (0)
struct XcdBarrier { unsigned* bar; unsigned x; volatile LAS unsigned* st; };
DI XcdBarrier xcd_barrier_post(unsigned* bar, volatile LAS unsigned* st) {
    XcdBarrier b; b.bar = bar; b.x = xb_xcc_id(); b.st = st;
    if (threadIdx.x == 0) (void)xb_add(&bar[XB_XCNT(b.x)], 1u);
    return b;
}
DI void xcd_barrier_complete(unsigned* bar, unsigned x, unsigned& nloc, unsigned& nx) {
    const unsigned G = gridDim.x * gridDim.y * gridDim.z;
    unsigned sum, cnt, mine, sp = 0u;
    for (;;) {
        sum = 0u; cnt = 0u; mine = 0u;
#pragma unroll
        for (unsigned j = 0; j < 16; ++j) { const unsigned c = xb_ld(&bar[XB_XCNT(j)]); sum += c; cnt += (c > 0u) ? 1u : 0u; mine = (j == x) ? c : mine; }
        if (sum == G) break;
        __builtin_amdgcn_s_sleep(1);
        if ((++sp & 255u) == 0u) { if (xb_ld(&bar[XB_TMO])) break; if (sp > XB_SPIN_CAP) { atomicAdd(&bar[XB_TMO], 1u); break; } }
    }
    nloc = mine > 0u ? mine : 1u; nx = cnt > 0u ? cnt : 1u;
}
DI void xcd_barrier(const XcdBarrier& b) {
    asm volatile("s_waitcnt vmcnt(0)" ::: "memory");
    __syncthreads();
    if (threadIdx.x == 0) {
        unsigned* bar = b.bar;
        __builtin_amdgcn_s_waitcnt(0);
        unsigned nloc = b.st[0], nx = b.st[1];
        if (nloc == 0u) { xcd_barrier_complete(bar, b.x, nloc, nx); b.st[0] = nloc; b.st[1] = nx; }
        const unsigned old = xb_add(&bar[XB_XSUB(b.x)], 1u);
        const unsigned gen = old / nloc;
        if (old + 1u == (gen + 1u) * nloc) {
            __builtin_amdgcn_fence(__ATOMIC_RELEASE, "agent");
            asm volatile("s_waitcnt vmcnt(0)" ::: "memory");
            const unsigned og = xb_add(&bar[XB_TOP], 1u);
            const unsigned tg = og / nx;
            if (og + 1u == (tg + 1u) * nx) xb_add(&bar[XB_TOPGEN], 1u);
            else XB_SPIN(xb_ld(&bar[XB_TOPGEN]) == tg, bar);
            __builtin_amdgcn_fence(__ATOMIC_ACQUIRE, "agent");
            xb_add(&bar[XB_XGEN(b.x)], 1u);
            asm volatile("s_waitcnt vmcnt(0)" ::: "memory");
        } else {
            XB_SPIN(xb_ld(&bar[XB_XGEN(b.x)]) == gen, bar);
            __builtin_amdgcn_fence(__ATOMIC_ACQUIRE, "agent");
            asm volatile("s_waitcnt vmcnt(0)" ::: "memory");
        }
    }
    __syncthreads();
}

struct WDesc { const float* src; bf16_t* dst; int K, N, mode, items; };
struct Params { const float* in[40]; float* out; unsigned char* ws; WDesc w[18]; int ph_lo, ph_hi; };

constexpr int LDS_BYTES = 147456;

__global__ void __launch_bounds__(512, 2) mega_fwd(Params P) {
    extern __shared__ __attribute__((aligned(16))) unsigned char lds_raw[];
    LAS unsigned char* lds = (LAS unsigned char*)lds_raw;
    cg::grid_group grid = cg::this_grid();
    volatile LAS unsigned* bst = (volatile LAS unsigned*)(lds + 131072 + 64);
    if (threadIdx.x == 0) { bst[0] = 0u; bst[1] = 0u; }
    __syncthreads();
    const XcdBarrier xbar = xcd_barrier_post((unsigned*)(P.ws + WS_BAR), bst);
    const int tid0 = threadIdx.x;
    const int G = gridDim.x, bx = blockIdx.x;
    const int ngw = G * 8;
    unsigned char* const ws0 = P.ws;
#define XB ((bf16_t*)(ws + WS_XB))
#define AO ((bf16_t*)(ws + WS_AO))
#define VT ((bf16_t*)(ws + WS_VT))
#define BIG ((bf16_t*)(ws + WS_BIG))
#define KMH ((bf16_t*)(ws + WS_KMH))
#define KML ((bf16_t*)(ws + WS_KML))
#define GWB ((bf16_t*)(ws + WS_GW))
#define MEMB ((bf16_t*)(ws + WS_MEMB))
#define STATS ((f32x2*)(ws + WS_STATS))
#define OUT (P.out)
    int ph = 0;
#define PH_LANE int tid = tid0; asm volatile("" : "+v"(tid)); unsigned char* ws = ws0; asm volatile("" : "+s"(ws)); const int lane = tid & 63, wave = __builtin_amdgcn_readfirstlane(tid >> 6), gw = bx * 8 + wave; (void)lane; (void)gw;
#if MK_ONE_LAUNCH
#define PH_BEGIN { PH_LANE
#define PH_END } xcd_barrier(xbar);
#define PH_END_LAST(last) } if (!(last)) xcd_barrier(xbar);
#define PH_END_CG } if (P.ph_lo > 0x40000000) grid.sync(); xcd_barrier(xbar);
#else
#define PH_BEGIN if (ph >= P.ph_lo && ph < P.ph_hi) { PH_LANE
#define PH_END } { if (ph >= P.ph_lo && ph + 1 < P.ph_hi) grid.sync(); ++ph; }
#define PH_END_CG PH_END
#define PH_END_LAST(last) PH_END
#endif

    PH_BEGIN
    {
        LAS float* scr = (LAS float*)(lds + wave * 8704);
        for (int rep = 0; rep < (PROBE == 5 ? 2 : 1); ++rep) {
        int rot = 0;
#pragma unroll 1
        for (int mi = 0; mi < 18; ++mi) {
            const WDesc d = P.w[mi];
            int v = gw - rot; if (v < 0) v += ngw;
            for (int it = v; it < d.items; it += ngw) transpose_item(d.src, d.K, d.N, d.dst, d.mode, scr, it, lane);
            rot = (rot + d.items) % ngw;
        }
        }
        const int gt = bx * 512 + tid, ngt = G * 512;
        cvt_rows(P.in[0], XB, (size_t)TOK * DM / 8, gt, ngt);
        cvt_rows(P.in[1], MEMB, (size_t)1024 * DM / 8, gt, ngt);
        for (int i = gt; i < TOK; i += ngt) STATS[i] = (f32x2){0.f, 1.f};
        for (int i = gt; i < DM; i += ngt) { ((float*)(ws + WS_LNG))[i] = 1.f; ((float*)(ws + WS_LNB))[i] = 0.f; }
        for (int i = gt; i < 8 * 128 * 128; i += ngt) { const int jj = i & 127, ii = (i >> 7) & 127; GWB[i] = (bf16_t)(cvtpk(jj <= ii ? P.in[9][i] : 0.f, 0.f) & 0xffffu); }
    }
    PH_END_CG

#pragma unroll 1
    for (int l = 0; l < 2; ++l) {
        const float* const* IN = P.in + (l == 0 ? 2 : 23);
        const int o_ln2 = (l == 0 ? 10 : 6);
#define WL (ws + WS_W + l * W_LAYER)
        PH_BEGIN
#if PROBE == 6
        { pg8::Gemm g{XB, (const bf16_t*)(WL + WO_FFN1I), TOK, 2 * DFF, DM}; pg8::StaticOrder S; S.init(TOK, 2 * DFF, G, bx);
          pg8::EpiSwiGLU E{0}; pg8::gemm_phase<pg8::EpiSwiGLU>(lds, g, S, E, tid); }
        asm volatile("" : "+v"(tid));
#endif
        { pg8::Gemm g{XB, (const bf16_t*)(WL + WO_FFN1I), TOK, 2 * DFF, DM}; pg8::StaticOrder S; S.init(TOK, 2 * DFF, G, bx);
          pg8::EpiSwiGLU E{0}; pg8::gemm_phase<pg8::EpiSwiGLU>(lds, g, S, E, tid); }
        { const int nfree = G - (43 * 64) % G;
          if (nfree >= 64 && nfree < G) { if (bx >= G - 64) {
              pg8::Gemm g{MEMB, (const bf16_t*)(WL + WO_MEMKV), 1024, 4096, DM}; pg8::StaticOrder S; S.init(1024, 4096, 64, bx - (G - 64));
              pg8::EpiBf16V E{l};
              pg8::gemm_phase<pg8::EpiBf16V>(lds, g, S, E, tid); } }
          else { pg8::Gemm g{MEMB, (const bf16_t*)(WL + WO_MEMKV), 1024, 4096, DM}; pg8::StaticOrder S; S.init(1024, 4096, G, bx);
              pg8::EpiBf16V E{l};
              pg8::gemm_phase<pg8::EpiBf16V>(lds, g, S, E, tid); } }
        PH_END
        PH_BEGIN
        { pg8::Gemm g{BIG, (const bf16_t*)(WL + WO_FFN1O), TOK, DM, DFF}; pg8::StaticOrder S; S.init(TOK, DM, G, bx);
          pg8::EpiResid E{l == 0 ? 3 : 2}; pg8::gemm_phase<pg8::EpiResid>(lds, g, S, E, tid); }
        PH_END
        PH_BEGIN
        ln_rows(OUT, nullptr, XB, STATS, IN[2], IN[3], gw, ngw, lane);
        PH_END
        PH_BEGIN
        if (l == 0) { pg8::Gemm g{XB, (const bf16_t*)(WL + WO_MIXI), TOK, LD0, DM}; pg8::StaticOrder S; S.init(TOK, LD0, G, bx);
          pg8::EpiBf16V E{2}; pg8::gemm_phase<pg8::EpiBf16V>(lds, g, S, E, tid); }
        else {
          { pg8::Gemm g{XB, (const bf16_t*)(WL + WO_MIXI), TOK, 4096, DM}; pg8::StaticOrder S; S.init(TOK, 4096, G, bx);
            pg8::EpiBf16V E{3}; pg8::gemm_phase<pg8::EpiBf16V>(lds, g, S, E, tid); }
          asm volatile("" : "+v"(tid));
          { pg8::Gemm g{(const bf16_t*)(WL + WO_MIXI) + (size_t)4096 * DM, XB, 2048, TOK, DM}; pg8::StaticOrder S; S.init(2048, TOK, G, bx);
            pg8::EpiBf16V E{5}; pg8::gemm_phase<pg8::EpiBf16V>(lds, g, S, E, tid); }
        }
        PH_END
        PH_BEGIN
        if (l == 0) {
#ifndef SKIP_B
            for (int rep = 0; rep < (PROBE == 3 ? 2 : 1); ++rep)
            for (int c = bx; c < 256; c += G) {
                const int ch = c >> 1, g0 = 2 * (c & 1);
                gmlp_unit(ch * 4 + g0, false, BIG, GWB, IN[5], IN[6], IN[8], AO, lds, wave, lane);
                gmlp_unit(ch * 4 + g0 + 1, true, BIG, GWB, IN[5], IN[6], IN[8], AO, lds, wave, lane);
            }
#endif
#ifndef SKIP_A
            for (int rep = 0; rep < (PROBE == 2 ? 2 : 1); ++rep)
            for (int it = gw; it < 4096; it += ngw) mixer_a_item(it, BIG, VT, AO, lane);
#endif
        } else {
            for (int rep = 0; rep < (PROBE == 1 ? 2 : 1); ++rep)
            for (int u = bx; u < 2048; u += G) {
                const int k = u >> 8, v = u & 255, bh = v >> 1, p = v & 1;
                const int n = (k & 1) ? (15 - (k - 1) - p) : (k + p);
                moba_unit(bh >> 5, bh & 31, n, BIG, VT, (const bf16_t*)(ws + WS_KP), KML, AO, lds, tid, wave, lane);
            }
        }
        PH_END
        PH_BEGIN
        { const int Kmix = (l == 0 ? 1536 : 2048);
          pg8::Gemm g{AO, (const bf16_t*)(WL + WO_MIXO), TOK, DM, Kmix}; pg8::StaticOrder S; S.init(TOK, DM, G, bx);
#if PROBE == 7

#endif
          pg8::EpiResid E{0}; pg8::gemm_phase<pg8::EpiResid>(lds, g, S, E, tid); }
        PH_END
        PH_BEGIN
#if PROBE == 8
        ln_rows(OUT, nullptr, BIG, (f32x2*)(BIG + 64 * MiB), IN[o_ln2], IN[o_ln2 + 1], gw, ngw, lane);
#endif
        ln_rows(OUT, nullptr, XB, STATS, IN[o_ln2], IN[o_ln2 + 1], gw, ngw, lane);
        PH_END
        PH_BEGIN
        { pg8::Gemm g{XB, (const bf16_t*)(WL + WO_MEMQ), TOK, DM, DM}; pg8::StaticOrder S; S.init(TOK, DM, G, bx);
          pg8::EpiBf16V E{4}; pg8::gemm_phase<pg8::EpiBf16V>(lds, g, S, E, tid); }
        PH_END
        PH_BEGIN

        for (int u = bx; u < 256; u += G) xattn_unit(u, BIG, (const bf16_t*)(ws + WS_MEMK + l * 4 * MiB), (const bf16_t*)(ws + WS_MEMVT + l * 4 * MiB), AO, lds, tid, wave, lane);
        PH_END
        PH_BEGIN
        { pg8::Gemm g{AO, (const bf16_t*)(WL + WO_MEMO), TOK, DM, DM}; pg8::StaticOrder S; S.init(TOK, DM, G, bx);
          pg8::EpiResid E{0}; pg8::gemm_phase<pg8::EpiResid>(lds, g, S, E, tid); }
        PH_END
        PH_BEGIN
        ln_rows(OUT, nullptr, XB, STATS, IN[o_ln2 + 5], IN[o_ln2 + 6], gw, ngw, lane);
        PH_END
        PH_BEGIN
        { pg8::Gemm g{XB, (const bf16_t*)(WL + WO_FFN2I), TOK, 2 * DFF, DM}; pg8::StaticOrder S; S.init(TOK, 2 * DFF, G, bx);
          pg8::EpiSwiGLU E{0}; pg8::gemm_phase<pg8::EpiSwiGLU>(lds, g, S, E, tid); }
        PH_END
        PH_BEGIN
        { pg8::Gemm g{BIG, (const bf16_t*)(WL + WO_FFN2O), TOK, DM, DFF}; pg8::StaticOrder S; S.init(TOK, DM, G, bx);
          pg8::EpiResid E{2}; pg8::gemm_phase<pg8::EpiResid>(lds, g, S, E, tid); }
        PH_END
        PH_BEGIN
        ln_rows(OUT, l == 1 ? OUT : nullptr, l == 1 ? nullptr : XB, STATS, IN[o_ln2 + 9], IN[o_ln2 + 10], gw, ngw, lane);
        PH_END_LAST(l == 1)
    }
#undef WL
#undef XB
#undef AO
#undef VT
#undef BIG
#undef KMH
#undef KML
#undef GWB
#undef MEMB
#undef STATS
#undef OUT
#undef PH_BEGIN
#undef PH_END
#undef PH_END_CG
#undef PH_END_LAST
}
constexpr int N_PHASES = 1 + 2 * 15;

extern "C" void kernel_launch(void* const* d_in, const int* in_sizes, int n_in, void* d_out, int out_size, void* d_ws, size_t ws_size, hipStream_t stream) {
    static int grid = 0;
    if (grid == 0) {
        if (n_in != 40 || in_sizes[0] != TOK * DM || out_size != TOK * DM || ws_size < WS_END) {
            fprintf(stderr, "kernel_launch: unexpected shapes / workspace (n_in %d, in0 %d, out %d, ws %zu < %zu)\n", n_in, n_in > 0 ? in_sizes[0] : -1, out_size, ws_size, (size_t)WS_END);
            grid = -1; return;
        }
        int dev = 0, cus = 0, per_cu = 0;
        hipGetDevice(&dev);
        hipDeviceGetAttribute(&cus, hipDeviceAttributeMultiprocessorCount, dev);
        if (hipFuncSetAttribute((const void*)mega_fwd, hipFuncAttributeMaxDynamicSharedMemorySize, LDS_BYTES) != hipSuccess) { fprintf(stderr, "kernel_launch: hipFuncSetAttribute failed\n"); grid = -1; return; }
        if (hipOccupancyMaxActiveBlocksPerMultiprocessor(&per_cu, (const void*)mega_fwd, 512, LDS_BYTES) != hipSuccess || per_cu < 1) { fprintf(stderr, "kernel_launch: occupancy query says %d\n", per_cu); per_cu = 1; }
        (void)hipGetLastError();
        grid = cus * (per_cu > 1 ? 1 : per_cu);
        fprintf(stderr, "kernel_launch: grid %d (cus %d, per_cu %d)\n", grid, cus, per_cu);
    }
    if (grid < 0) return;
    Params p{};
    for (int i = 0; i < 40; ++i) p.in[i] = (const float*)d_in[i];
    p.out = (float*)d_out; p.ws = (unsigned char*)d_ws;
    unsigned char* ws = (unsigned char*)d_ws;
    int wi = 0;
    for (int l = 0; l < 2; ++l) {
        const int base = (l == 0 ? 2 : 23);
        const int i_mixi = base + 4, i_mixo = (l == 0 ? base + 9 : base + 5), i_ln2 = (l == 0 ? base + 10 : base + 6);
        unsigned char* WL = ws + WS_W + l * W_LAYER;
        auto add = [&](int idx, size_t off, int K, int N, int mode) { WDesc& d = p.w[wi++]; d.src = (const float*)d_in[idx]; d.dst = (bf16_t*)(WL + off); d.K = K; d.N = N; d.mode = mode; d.items = (K / 64) * (N / 32); };
        add(base + 0, WO_FFN1I, DM, 2 * DFF, 1);
        add(base + 1, WO_FFN1O, DFF, DM, 0);
        add(i_mixi, WO_MIXI, DM, l == 0 ? LD0 : LD1, 0);
        add(i_mixo, WO_MIXO, l == 0 ? 1536 : 2048, DM, 0);
        add(i_ln2 + 2, WO_MEMQ, DM, DM, 0);
        add(i_ln2 + 3, WO_MEMKV, DM, 2 * DM, 0);
        add(i_ln2 + 4, WO_MEMO, DM, DM, 0);
        add(i_ln2 + 7, WO_FFN2I, DM, 2 * DFF, 1);
        add(i_ln2 + 8, WO_FFN2O, DFF, DM, 0);
    }
#if MK_ONE_LAUNCH
    if (hipMemsetAsync(ws + WS_BAR, 0, BAR_BYTES, stream) != hipSuccess) { fprintf(stderr, "kernel_launch: memset failed\n"); return; }
    p.ph_lo = 0; p.ph_hi = N_PHASES;
    void* args[] = {&p};
    hipError_t e = hipLaunchCooperativeKernel((const void*)mega_fwd, dim3(grid), dim3(512), args, LDS_BYTES, stream);
    if (e != hipSuccess) fprintf(stderr, "kernel_launch: cooperative launch failed: %s (grid %d)\n", hipGetErrorString(e), grid);
#else
    for (int ph = 0; ph < N_PHASES; ++ph) {
        p.ph_lo = ph; p.ph_hi = ph + 1;
        hipLaunchKernelGGL(mega_fwd, dim3(grid), dim3(512), LDS_BYTES, stream, p);
    }
#endif
}
```
